# Optimizing an MI355X kernel written in HIP

```python
import jax, jax.numpy as jnp
from jax import lax
import numpy as np

D_MODEL = 2048
BATCH = 8
SEQ = 2048
DEPTH = 1

CHUNK = 64
SUB_CHUNK = 16
N_SUB = CHUNK // SUB_CHUNK

A_HEADS = 8
A_HEAD_DIM = 128
A_WIDTH = A_HEADS * A_HEAD_DIM
B_HEADS = 4
B_KEY_DIM = 128
B_VAL_DIM = 256
B_KEY_WIDTH = B_HEADS * B_KEY_DIM
B_VAL_WIDTH = B_HEADS * B_VAL_DIM
GK_RANK = 16
GATE_LOGIT_NORMALIZER = 16.0
IN_WIDTH = 4 * A_WIDTH + 2 * B_KEY_WIDTH + 2 * B_VAL_WIDTH + GK_RANK + 2 * D_MODEL
FFN_HIDDEN = -(-(8 * D_MODEL) // (3 * 256)) * 256
N_MOD = 6
EPS = 1e-6

kernel_name = "hgrn2_gla_parallel_hybrid_adaln"


def _in_split_points():
    sizes = [A_WIDTH] * 4 + [B_KEY_WIDTH] * 2 + [B_VAL_WIDTH] * 2 + [GK_RANK, D_MODEL, D_MODEL]
    return [int(v) for v in np.cumsum(sizes)[:-1]]


def rmsnorm(x, w):
    x32 = x.astype(jnp.float32)
    y = x32 * lax.rsqrt(jnp.mean(x32 * x32, axis=-1, keepdims=True) + EPS)
    return (y * w.astype(jnp.float32)).astype(x.dtype)


def to_heads(t, n_heads):
    b, s, hd = t.shape
    return t.reshape(b, s, n_heads, hd // n_heads).transpose(0, 2, 1, 3)


def gated_head_rmsnorm(o, gate, w):
    b, h, t, dv = o.shape
    y = o * lax.rsqrt(jnp.mean(o * o, axis=-1, keepdims=True) + EPS) * w.astype(jnp.float32)
    y = y.transpose(0, 2, 1, 3).reshape(b, t, h * dv)
    return (y * jax.nn.silu(gate.astype(jnp.float32))).astype(gate.dtype)


def chunked_gated_linear_recurrence(q, k, v, g):
    out_dtype = v.dtype
    q, k, v, g = (t.astype(jnp.float32) for t in (q, k, v, g))
    bsz, nh, seq, dk = q.shape
    dv = v.shape[-1]
    nc = seq // CHUNK

    def to_chunks(t):
        return t.reshape(bsz, nh, nc, CHUNK, t.shape[-1]).transpose(2, 0, 1, 3, 4)

    sub_idx = jnp.arange(CHUNK) // SUB_CHUNK
    mask_off = sub_idx[None, :] < jnp.arange(N_SUB)[:, None]
    mask_diag = jnp.tril(jnp.ones((SUB_CHUNK, SUB_CHUNK), dtype=bool))
    eye_sub = jnp.eye(N_SUB, dtype=jnp.float32)

    def step(state, inp):
        qc, kc, vc, gc = inp
        b = jnp.cumsum(gc, axis=2)
        o_inter = jnp.einsum('bhid,bhde->bhie', qc * jnp.exp(b), state)
        bs = b.reshape(bsz, nh, N_SUB, SUB_CHUNK, dk)
        qs = qc.reshape(bsz, nh, N_SUB, SUB_CHUNK, dk)
        ks = kc.reshape(bsz, nh, N_SUB, SUB_CHUNK, dk)
        ref = jnp.concatenate([jnp.zeros_like(bs[:, :, :1, -1]), bs[:, :, :-1, -1]], axis=2)
        q_off = qs * jnp.exp(bs - ref[:, :, :, None, :])
        expo_off = jnp.where(mask_off[None, None, :, :, None],
                             ref[:, :, :, None, :] - b[:, :, None, :, :], -jnp.inf)
        k_off = kc[:, :, None] * jnp.exp(expo_off)
        a_off = jnp.einsum('bhsid,bhsjd->bhsij', q_off, k_off)
        expo_d = jnp.where(mask_diag[None, None, None, :, :, None],
                           bs[:, :, :, :, None, :] - bs[:, :, :, None, :, :], -jnp.inf)
        a_diag = jnp.sum(qs[:, :, :, :, None, :] * ks[:, :, :, None, :, :] * jnp.exp(expo_d), axis=-1)
        a_diag = jnp.einsum('bhsij,sr->bhsirj', a_diag, eye_sub).reshape(bsz, nh, N_SUB, SUB_CHUNK, CHUNK)
        attn = a_off + a_diag
        o_intra = jnp.einsum('bhsij,bhje->bhsie', attn, vc).reshape(bsz, nh, CHUNK, dv)
        b_last = b[:, :, -1]
        k_dec = kc * jnp.exp(b_last[:, :, None, :] - b)
        new_state = jnp.exp(b_last)[..., None] * state + jnp.einsum('bhjd,bhje->bhde', k_dec, vc)
        return new_state, o_inter + o_intra

    state0 = jnp.zeros((bsz, nh, dk, dv), jnp.float32)
    _, o = lax.scan(step, state0, (to_chunks(q), to_chunks(k), to_chunks(v), to_chunks(g)))
    o = o.transpose(1, 2, 0, 3, 4).reshape(bsz, nh, seq, dv)
    return o.astype(out_dtype) if out_dtype != jnp.float32 else o


def hybrid_mixer(h, lower_bound, w_in, w_gk2, b_gk2, a_norm_w, b_norm_w, w_up_a, w_up_b, w_o):
    proj = h @ w_in
    (qa, fa, ia, ga, qb, kb, vb, gb, gk_low, ma, mb) = jnp.split(proj, _in_split_points(), axis=-1)
    f = lower_bound + (1.0 - lower_bound) * jax.nn.sigmoid(fa.astype(jnp.float32))
    o_a = chunked_gated_linear_recurrence(
        to_heads(jax.nn.silu(qa), A_HEADS), to_heads(1.0 - f, A_HEADS),
        to_heads(ia, A_HEADS), to_heads(jnp.log(f), A_HEADS))
    y_a = gated_head_rmsnorm(o_a.astype(jnp.float32), ga, a_norm_w)
    gk = jax.nn.log_sigmoid((gk_low @ w_gk2 + b_gk2).astype(jnp.float32)) / GATE_LOGIT_NORMALIZER
    o_b = chunked_gated_linear_recurrence(
        to_heads(qb, B_HEADS) * (B_KEY_DIM ** -0.5), to_heads(kb, B_HEADS),
        to_heads(vb, B_HEADS), to_heads(gk, B_HEADS))
    y_b = gated_head_rmsnorm(o_b.astype(jnp.float32), gb, b_norm_w)
    merged = jax.nn.sigmoid(ma) * (y_a @ w_up_a) + jax.nn.sigmoid(mb) * (y_b @ w_up_b)
    return merged @ w_o


def swiglu(h, w_ffn_in, w_ffn_out):
    gate, up = jnp.split(h @ w_ffn_in, 2, axis=-1)
    return (jax.nn.silu(gate) * up) @ w_ffn_out


def setup_inputs(seed: int = 0) -> dict:
    key = jax.random.key(seed)
    ks = jax.random.split(key, 20)
    D, L = D_MODEL, DEPTH

    def nrm(k, shape, s):
        return jax.random.normal(k, shape, jnp.float32) * s

    return {
        "x": nrm(ks[0], (BATCH, SEQ, D), 1.0),
        "c": nrm(ks[1], (BATCH, D), 1.0),
        "w_ada": nrm(ks[2], (L, D, N_MOD * D), 0.5 * D ** -0.5),
        "b_ada": nrm(ks[3], (L, N_MOD * D), 0.01),
        "norm1_w": 1.0 + nrm(ks[4], (L, D), 0.02),
        "w_in": nrm(ks[5], (L, D, IN_WIDTH), D ** -0.5),
        "w_gk2": nrm(ks[6], (L, GK_RANK, B_KEY_WIDTH), GK_RANK ** -0.5),
        "b_gk2": nrm(ks[7], (L, B_KEY_WIDTH), 0.01),
        "lb_param": nrm(ks[8], (L + 1, A_WIDTH), 0.5),
        "a_norm_w": 1.0 + nrm(ks[9], (L, A_HEAD_DIM), 0.02),
        "b_norm_w": 1.0 + nrm(ks[10], (L, B_VAL_DIM), 0.02),
        "w_up_a": nrm(ks[11], (L, A_WIDTH, D), A_WIDTH ** -0.5),
        "w_up_b": nrm(ks[12], (L, B_VAL_WIDTH, D), B_VAL_WIDTH ** -0.5),
        "w_o": nrm(ks[13], (L, D, D), D ** -0.5),
        "norm2_w": 1.0 + nrm(ks[14], (L, D), 0.02),
        "w_ffn_in": nrm(ks[15], (L, D, 2 * FFN_HIDDEN), D ** -0.5),
        "w_ffn_out": nrm(ks[16], (L, FFN_HIDDEN, D), FFN_HIDDEN ** -0.5),
        "final_norm_w": 1.0 + nrm(ks[17], (D,), 0.02),
    }


def reference(x, c, w_ada, b_ada, norm1_w, w_in, w_gk2, b_gk2, lb_param, a_norm_w, b_norm_w,
              w_up_a, w_up_b, w_o, norm2_w, w_ffn_in, w_ffn_out, final_norm_w):
    lb_all = jnp.cumsum(jax.nn.softmax(lb_param.astype(jnp.float32), axis=0), axis=0)
    cond = jax.nn.silu(c)
    for l in range(DEPTH):
        mod = (cond @ w_ada[l] + b_ada[l])[:, None, :]
        sh1, sc1, gt1, sh2, sc2, gt2 = jnp.split(mod, N_MOD, axis=-1)
        h = rmsnorm(x, norm1_w[l]) * (1.0 + sc1) + sh1
        x = x + gt1 * hybrid_mixer(h, lb_all[l], w_in[l], w_gk2[l], b_gk2[l], a_norm_w[l], b_norm_w[l],
                                   w_up_a[l], w_up_b[l], w_o[l])
        h = rmsnorm(x, norm2_w[l]) * (1.0 + sc2) + sh2
        x = x + gt2 * swiglu(h, w_ffn_in[l], w_ffn_out[l])
    return rmsnorm(x, final_norm_w)
```

```cpp
#include <hip/hip_runtime.h>
#include <hip/hip_cooperative_groups.h>
#include <cstdio>
#include <cstdint>
namespace cg = cooperative_groups;

#ifndef ONE_LAUNCH
#define ONE_LAUNCH 1
#endif
#ifndef USE_CG_SYNC
#define USE_CG_SYNC 0
#endif
#ifndef NAIVE_GEMM
#define NAIVE_GEMM 0
#endif

#define LAS __attribute__((address_space(3)))
typedef unsigned short bf16_t;
typedef short bf16x8 __attribute__((ext_vector_type(8)));
typedef float f32x4 __attribute__((ext_vector_type(4)));
typedef unsigned u32x4 __attribute__((ext_vector_type(4)));
typedef unsigned u32x2 __attribute__((ext_vector_type(2)));

constexpr int NTOK = 16384, DM = 2048;
constexpr int PREC_W = 7168, PM_W = 4096 + 64, FFH = 5632, INW = 11280, NMOD = 12288;
constexpr float EPS = 1e-6f;
constexpr int XST_OFF = 163072;
constexpr int XP = 2048 + 32;
constexpr int MP = 2048 + 64;
constexpr int LDS_BYTES = XST_OFF + 64;
constexpr int NPHASE = 11;

constexpr size_t OFF_WT_IN  = 0;
constexpr size_t OFF_WT_UPA = OFF_WT_IN + (size_t)11264 * 2048 * 2;
constexpr size_t OFF_WT_UPB = OFF_WT_UPA + (size_t)2048 * 1024 * 2;
constexpr size_t OFF_WT_O   = OFF_WT_UPB + (size_t)2048 * 1024 * 2;
constexpr size_t OFF_WT_FFI = OFF_WT_O + (size_t)2048 * 2048 * 2;
constexpr size_t OFF_WT_FFO = OFF_WT_FFI + (size_t)11264 * 2048 * 2;
constexpr size_t OFF_MOD    = OFF_WT_FFO + (size_t)2048 * 5632 * 2;
constexpr size_t OFF_GKL    = OFF_MOD + (size_t)8 * 12288 * 4;
constexpr size_t OFF_PREC   = OFF_GKL + (size_t)16384 * 16 * 4;
constexpr size_t OFF_PM     = OFF_PREC + (size_t)16384 * 7168 * 2;
constexpr size_t OFF_BAR    = OFF_PM + (size_t)16384 * PM_W * 2;
constexpr size_t BAR_BYTES  = 16384;
constexpr size_t OFF_GDEC   = OFF_BAR + BAR_BYTES;
constexpr size_t OFF_GRAN   = OFF_GDEC + (size_t)16384 * 512 * 2;
constexpr size_t GRAN_BYTES = (size_t)256 * 32 * 64 * 8;
constexpr size_t WS_END     = OFF_GRAN + GRAN_BYTES;

struct Params {
    const float *x, *c, *w_ada, *b_ada, *norm1_w, *w_in, *w_gk2, *b_gk2, *lb_param, *a_norm_w, *b_norm_w, *w_up_a, *w_up_b, *w_o, *norm2_w, *w_ffn_in, *w_ffn_out, *final_norm_w;
    float* out; unsigned char* ws;
    int phase_lo, phase_hi;
};

__device__ __forceinline__ unsigned pk2(float lo, float hi) { unsigned r; asm("v_cvt_pk_bf16_f32 %0, %1, %2" : "=v"(r) : "v"(lo), "v"(hi)); return r; }
__device__ __forceinline__ float bflo(unsigned u) { return __uint_as_float(u << 16); }
__device__ __forceinline__ float bfhi(unsigned u) { return __uint_as_float(u & 0xffff0000u); }
__device__ __forceinline__ float bf1(bf16_t b) { return __uint_as_float(((unsigned)b) << 16); }
__device__ __forceinline__ float sigmoidf_(float v) { return __builtin_amdgcn_rcpf(1.f + __expf(-v)); }
__device__ __forceinline__ float siluf_(float v) { return v * sigmoidf_(v); }
__device__ __forceinline__ int opaque_tid() { int t = threadIdx.x; asm volatile("" : "+v"(t)); return t; }
__device__ __forceinline__ float wave_sum(float v) {
#pragma unroll
    for (int o = 1; o < 64; o <<= 1) v += __shfl_xor(v, o);
    return v;
}

namespace pg8 {
constexpr int BM = 256, BK = 64, HALF = 128, HTB = HALF * BK * 2, STAGE_BYTES = 8 * HTB, NXCD = 8, WGM = 8;
__host__ __device__ __forceinline__ int lds_byte(int r, int c) { const int st = (r >> 4) * 2 + (c >> 5), rr = r & 15, cc = c & 31, ob = rr * 64 + cc * 2; return st * 1024 + (ob ^ (((ob >> 9) & 1) << 5)); }
__host__ __device__ __forceinline__ void stage_rc(int b, int& R, int& C) { const int st = b / 1024, sb = b % 1024, swz = sb ^ (((sb >> 9) & 1) << 5); R = (st >> 1) * 16 + swz / 64; C = (st & 1) * 32 + (swz % 64) / 2; }
__host__ __device__ __forceinline__ int perm32(int rho) { const int n = rho >> 4, i = rho & 15; return 8 * (i >> 2) + 4 * n + (i & 3); }

struct Unit { int pm, pn, aux; const char* A; const char* B; };

struct Sched {
    int nM, nN, nwg, G, c, pairs;
    const char *A0, *A1, *B0, *B1; size_t atile, btile;
    __device__ __forceinline__ bool next(int i, Unit& u) const {
        const int ti = pairs ? (i >> 1) : i, s = pairs ? (i & 1) : 0;
        const long L = (long)ti * G + c; if (L >= nwg) return false;
        int wgid = (int)L; { const int q = nwg / NXCD, r = nwg % NXCD, xcd = wgid % NXCD, off = wgid / NXCD; wgid = (xcd < r ? xcd * (q + 1) : r * (q + 1) + (xcd - r) * q) + off; }
        const int nig = WGM * nN, gid = wgid / nig, fm = gid * WGM, gsz = (nM - fm) < WGM ? (nM - fm) : WGM;
        u.pm = fm + ((wgid % nig) % gsz); u.pn = (wgid % nig) / gsz; u.aux = s;
        u.A = (s ? A1 : A0) + (size_t)u.pm * atile; u.B = (s ? B1 : B0) + (size_t)u.pn * btile; return true;
    }
};

#if !NAIVE_GEMM
template <class Epi>
__device__ __forceinline__ void gemm_phase(LAS unsigned char* lds, const int K, const int lda, const int ldb, const Sched& S, const Epi& E) {
    int tid_ = threadIdx.x; asm volatile("" : "+v"(tid_));
    const int tid = tid_, wid = __builtin_amdgcn_readfirstlane(tid >> 6), lane = tid & 63, wr = wid >> 2, wc = wid & 3, fr = lane & 15, fq = lane >> 4;
    const int nt = K / BK;
    unsigned voffA[2], voffB[2];
#pragma unroll
    for (int i = 0; i < 2; ++i) { int R, C; stage_rc(tid * 16 + i * 8192, R, C); const int Rb = (R & ~31) + perm32(R & 31);
        voffA[i] = (unsigned)(R * lda + C) * 2u; voffB[i] = (unsigned)(Rb * ldb + C) * 2u; }
    const size_t kstep = (size_t)(BK * 2);
    const size_t hstepA = (size_t)HALF * lda * 2, hstepB = (size_t)HALF * ldb * 2;
    const unsigned ldsw = (unsigned)wid * 1024u;
    const int aoff = lds_byte(wr * 64 + fr, fq * 8), boff = lds_byte(wc * 32 + fr, fq * 8);
#define PG8_SA(b, h) (((b) * 2 + (h)) * HTB)
#define PG8_SB(b, h) ((4 + (b) * 2 + (h)) * HTB)
#define PG8_STAGE(bufoff, gbase, voff) do { _Pragma("unroll") for (int _i = 0; _i < 2; ++_i) \
        __builtin_amdgcn_global_load_lds((const unsigned*)((const char*)(gbase) + (voff)[_i]), (LAS unsigned*)(lds + (bufoff) + ldsw + _i * 8192), 16, 0, 0); } while (0)
#define PG8_LDA(dst, b, h) do { _Pragma("unroll") for (int m = 0; m < 4; ++m) _Pragma("unroll") for (int k = 0; k < 2; ++k) dst[m][k] = *(const LAS bf16x8*)(lds + PG8_SA(b, h) + aoff + m * 2048 + k * 1024); } while (0)
#define PG8_LDB(dst, b, h) do { _Pragma("unroll") for (int n = 0; n < 2; ++n) _Pragma("unroll") for (int k = 0; k < 2; ++k) dst[n][k] = *(const LAS bf16x8*)(lds + PG8_SB(b, h) + boff + n * 2048 + k * 1024); } while (0)
#define PG8_MMA(ai, bj, At, Bt) do { __builtin_amdgcn_s_setprio(1); _Pragma("unroll") for (int m = 0; m < 4; ++m) _Pragma("unroll") for (int n = 0; n < 2; ++n) _Pragma("unroll") for (int k = 0; k < 2; ++k) \
        acc[ai][bj][m][n] = __builtin_amdgcn_mfma_f32_16x16x32_bf16(Bt[n][k], At[m][k], acc[ai][bj][m][n], 0, 0, 0); __builtin_amdgcn_s_setprio(0); } while (0)
#define PG8_WAIT_V(n) asm volatile("s_waitcnt vmcnt(" #n ")" ::: "memory")
#define PG8_WAIT_L(n) asm volatile("s_waitcnt lgkmcnt(" #n ")" ::: "memory")
#define PG8_BAR __builtin_amdgcn_s_barrier()
#define PG8_SCHED __builtin_amdgcn_sched_barrier(0)
    Unit cur, nxt; int ui = 0;
    if (!S.next(0, cur)) return;
    f32x4 acc[2][2][4][2];
#pragma unroll
    for (int a = 0; a < 2; ++a)
#pragma unroll
        for (int b = 0; b < 2; ++b)
#pragma unroll
            for (int m = 0; m < 4; ++m)
#pragma unroll
                for (int n = 0; n < 2; ++n) acc[a][b][m][n] = (f32x4){0.f, 0.f, 0.f, 0.f};
    bf16x8 At[4][2], B0[2][2], B1[2][2];
    const char* cA = cur.A; const char* cB = cur.B;
    PG8_STAGE(PG8_SB(0, 0), cB, voffB); PG8_STAGE(PG8_SA(0, 0), cA, voffA); PG8_STAGE(PG8_SB(0, 1), cB + hstepB, voffB); PG8_STAGE(PG8_SA(0, 1), cA + hstepA, voffA);
    if (wr == 1) PG8_BAR;
    PG8_WAIT_V(4); PG8_BAR;
    PG8_STAGE(PG8_SB(1, 0), cB + kstep, voffB); PG8_STAGE(PG8_SA(1, 0), cA + kstep, voffA); PG8_STAGE(PG8_SB(1, 1), cB + hstepB + kstep, voffB);
    PG8_WAIT_V(6); PG8_BAR;
    for (;;) {
        const bool has_next = S.next(ui + 1, nxt);
        const char* nA = has_next ? nxt.A : cA; const char* nB = has_next ? nxt.B : cB;
        for (int t = 0; t < nt; t += 2) {
            const bool last = (t == nt - 2);
            const char* a1 = cA + (size_t)(t + 1) * kstep;
            const char* a2 = last ? nA : cA + (size_t)(t + 2) * kstep; const char* b2 = last ? nB : cB + (size_t)(t + 2) * kstep;
            const char* a3 = a2 + kstep; const char* b3 = b2 + kstep;
            PG8_LDB(B0, 0, 0); PG8_SCHED; PG8_LDA(At, 0, 0); PG8_STAGE(PG8_SA(1, 1), a1 + hstepA, voffA);
            PG8_WAIT_L(8); PG8_BAR; PG8_WAIT_L(0); PG8_MMA(0, 0, At, B0); PG8_BAR; PG8_SCHED;
            PG8_LDB(B1, 0, 1); PG8_STAGE(PG8_SB(0, 0), b2, voffB);
            PG8_BAR; PG8_WAIT_L(0); PG8_MMA(0, 1, At, B1); PG8_BAR;
            PG8_LDA(At, 0, 1); PG8_STAGE(PG8_SA(0, 0), a2, voffA);
            PG8_BAR; PG8_WAIT_L(0); PG8_MMA(1, 0, At, B0); PG8_BAR; PG8_SCHED;
            PG8_STAGE(PG8_SB(0, 1), b2 + hstepB, voffB);
            PG8_WAIT_V(6); PG8_BAR; PG8_MMA(1, 1, At, B1); PG8_BAR;
            PG8_LDB(B0, 1, 0); PG8_SCHED; PG8_LDA(At, 1, 0); PG8_STAGE(PG8_SA(0, 1), a2 + hstepA, voffA);
            PG8_WAIT_L(8); PG8_BAR; PG8_WAIT_L(0); PG8_MMA(0, 0, At, B0); PG8_BAR; PG8_SCHED;
            PG8_LDB(B1, 1, 1); PG8_STAGE(PG8_SB(1, 0), b3, voffB);
            PG8_BAR; PG8_WAIT_L(0); PG8_MMA(0, 1, At, B1); PG8_BAR;
            PG8_LDA(At, 1, 1); PG8_STAGE(PG8_SA(1, 0), a3, voffA);
            PG8_BAR; PG8_WAIT_L(0); PG8_MMA(1, 0, At, B0); PG8_BAR; PG8_SCHED;
            PG8_STAGE(PG8_SB(1, 1), b3 + hstepB, voffB);
            PG8_WAIT_V(6); PG8_BAR; PG8_MMA(1, 1, At, B1); PG8_BAR;
        }
        E(acc, cur, wr, wc, fr, fq);
        if (!has_next) break;
        if (!(Epi::KEEP_ACC && cur.aux == 0)) {
#pragma unroll
        for (int a = 0; a < 2; ++a)
#pragma unroll
            for (int b = 0; b < 2; ++b)
#pragma unroll
                for (int m = 0; m < 4; ++m)
#pragma unroll
                    for (int n = 0; n < 2; ++n) acc[a][b][m][n] = (f32x4){0.f, 0.f, 0.f, 0.f};
        }
        cur = nxt; cA = nA; cB = nB; ++ui;
    }
    PG8_WAIT_V(0);
    if (wr == 0) PG8_BAR;
    PG8_BAR;
#undef PG8_SA
#undef PG8_SB
#undef PG8_STAGE
#undef PG8_LDA
#undef PG8_LDB
#undef PG8_MMA
#undef PG8_WAIT_V
#undef PG8_WAIT_L
#undef PG8_BAR
#undef PG8_SCHED
}
#else
template <class Epi>
__device__ __forceinline__ void gemm_phase(LAS unsigned char* lds, const int K, const int lda, const int ldb, const Sched& S, const Epi& E) {
    const int tid = opaque_tid(), wid = tid >> 6, lane = tid & 63, wr = wid >> 2, wc = wid & 3, fr = lane & 15, fq = lane >> 4;
    Unit cur;
    f32x4 acc[2][2][4][2];
    for (int ui = 0; S.next(ui, cur); ++ui) {
        if (!(Epi::KEEP_ACC && cur.aux == 1))
#pragma unroll
        for (int a = 0; a < 2; ++a)
#pragma unroll
            for (int b = 0; b < 2; ++b)
#pragma unroll
                for (int m = 0; m < 4; ++m)
#pragma unroll
                    for (int n = 0; n < 2; ++n) acc[a][b][m][n] = (f32x4){0.f, 0.f, 0.f, 0.f};
        for (int kb = 0; kb < K; kb += 32) {
#pragma unroll
            for (int ai = 0; ai < 2; ++ai)
#pragma unroll
                for (int bj = 0; bj < 2; ++bj) {
                    bf16x8 bf[2];
#pragma unroll
                    for (int n = 0; n < 2; ++n) bf[n] = *(const bf16x8*)(cur.B + ((size_t)(bj * 128 + wc * 32 + perm32(16 * n + fr)) * ldb + kb + fq * 8) * 2);
#pragma unroll
                    for (int m = 0; m < 4; ++m) {
                        const bf16x8 af = *(const bf16x8*)(cur.A + ((size_t)(ai * 128 + wr * 64 + m * 16 + fr) * lda + kb + fq * 8) * 2);
#pragma unroll
                        for (int n = 0; n < 2; ++n) acc[ai][bj][m][n] = __builtin_amdgcn_mfma_f32_16x16x32_bf16(bf[n], af, acc[ai][bj][m][n], 0, 0, 0);
                    }
                }
        }
        E(acc, cur, wr, wc, fr, fq);
    }
}
#endif
}
using pg8::Unit;

struct EpiG1 {
    static constexpr bool KEEP_ACC = false;
    bf16_t* prec; bf16_t* pm_;
    __device__ __forceinline__ void operator()(const f32x4 (&acc)[2][2][4][2], const Unit& u, int wr, int wc, int fr, int fq) const {
        const int pn = u.pn;
        const int act = pn < 4 ? 1 : (pn >= 28 ? 2 : ((pn == 16 || pn == 17) ? 3 : 0));
        bf16_t* base; int ld, c0;
        if (pn < 28) { base = prec; ld = PREC_W; c0 = pn * 256; } else { base = pm_; ld = PM_W; c0 = (pn - 28) * 256; }
#pragma unroll
        for (int ai = 0; ai < 2; ++ai)
#pragma unroll
            for (int m = 0; m < 4; ++m) {
                const int row = u.pm * 256 + ai * 128 + wr * 64 + m * 16 + fr;
                bf16_t* rp = base + (size_t)row * ld + c0 + wc * 32 + 8 * fq;
#pragma unroll
                for (int bj = 0; bj < 2; ++bj) {
                    f32x4 v0 = acc[ai][bj][m][0], v1 = acc[ai][bj][m][1];
                    if (act == 1) {
#pragma unroll
                        for (int j = 0; j < 4; ++j) { v0[j] = siluf_(v0[j]); v1[j] = siluf_(v1[j]); }
                    } else if (act == 2) {
#pragma unroll
                        for (int j = 0; j < 4; ++j) { v0[j] = sigmoidf_(v0[j]); v1[j] = sigmoidf_(v1[j]); }
                    } else if (act == 3) { v0 = v0 * 0.08838834764831845f; v1 = v1 * 0.08838834764831845f; }
                    __builtin_nontemporal_store((u32x4){pk2(v0[0], v0[1]), pk2(v0[2], v0[3]), pk2(v1[0], v1[1]), pk2(v1[2], v1[3])}, (u32x4*)(rp + bj * 128));
                }
            }
    }
};
struct EpiG2 {
    static constexpr bool KEEP_ACC = true;
    bf16_t* merged; const bf16_t* pm_;
    __device__ __forceinline__ void operator()(f32x4 (&acc)[2][2][4][2], const Unit& u, int wr, int wc, int fr, int fq) const {
        const int s = u.aux;
#pragma unroll
        for (int ai = 0; ai < 2; ++ai)
#pragma unroll
            for (int m = 0; m < 4; ++m) {
                const int row = u.pm * 256 + ai * 128 + wr * 64 + m * 16 + fr;
#pragma unroll
                for (int bj = 0; bj < 2; ++bj) {
                    const int c = u.pn * 256 + bj * 128 + wc * 32 + 8 * fq;
                    const u32x4 gb = *(const u32x4*)(pm_ + (size_t)row * PM_W + 2048 + c);
                    if (s == 0) {
                        const u32x4 ga = *(const u32x4*)(pm_ + (size_t)row * PM_W + c);
#pragma unroll
                        for (int q = 0; q < 2; ++q) {
                            acc[ai][bj][m][0][2 * q] *= bflo(ga[q]) * __builtin_amdgcn_rcpf(bflo(gb[q])); acc[ai][bj][m][0][2 * q + 1] *= bfhi(ga[q]) * __builtin_amdgcn_rcpf(bfhi(gb[q]));
                            acc[ai][bj][m][1][2 * q] *= bflo(ga[2 + q]) * __builtin_amdgcn_rcpf(bflo(gb[2 + q])); acc[ai][bj][m][1][2 * q + 1] *= bfhi(ga[2 + q]) * __builtin_amdgcn_rcpf(bfhi(gb[2 + q]));
                        }
                    } else {
                        const f32x4 a0 = acc[ai][bj][m][0], a1 = acc[ai][bj][m][1];
                        float v[8];
                        v[0] = a0[0] * bflo(gb[0]); v[1] = a0[1] * bfhi(gb[0]); v[2] = a0[2] * bflo(gb[1]); v[3] = a0[3] * bfhi(gb[1]);
                        v[4] = a1[0] * bflo(gb[2]); v[5] = a1[1] * bfhi(gb[2]); v[6] = a1[2] * bflo(gb[3]); v[7] = a1[3] * bfhi(gb[3]);
                        *(u32x4*)(merged + (size_t)row * DM + c) = (u32x4){pk2(v[0], v[1]), pk2(v[2], v[3]), pk2(v[4], v[5]), pk2(v[6], v[7])};
                    }
                }
            }
    }
};
template <bool IN_BF16> struct EpiResT {
    static constexpr bool KEEP_ACC = false;
    const void* xin; bf16_t* xout; const float* gt; int ldi, ldo;
    __device__ __forceinline__ void operator()(const f32x4 (&acc)[2][2][4][2], const Unit& u, int wr, int wc, int fr, int fq) const {
        const int b = (u.pm * 256) >> 11;
#pragma unroll
        for (int bj = 0; bj < 2; ++bj) {
            const int c = u.pn * 256 + bj * 128 + wc * 32 + 8 * fq;
            const f32x4 g0 = *(const f32x4*)(gt + (size_t)b * NMOD + c), g1 = *(const f32x4*)(gt + (size_t)b * NMOD + c + 4);
#pragma unroll
            for (int ai = 0; ai < 2; ++ai)
#pragma unroll
                for (int m = 0; m < 4; ++m) {
                    const int row = u.pm * 256 + ai * 128 + wr * 64 + m * 16 + fr;
                    f32x4 x0, x1;
                    if (IN_BF16) { const u32x4 xv = *(const u32x4*)((const bf16_t*)xin + (size_t)row * ldi + c);
                        x0 = (f32x4){bflo(xv[0]), bfhi(xv[0]), bflo(xv[1]), bfhi(xv[1])}; x1 = (f32x4){bflo(xv[2]), bfhi(xv[2]), bflo(xv[3]), bfhi(xv[3])}; }
                    else { const float* ip = (const float*)xin + (size_t)row * ldi + c; x0 = *(const f32x4*)ip; x1 = *(const f32x4*)(ip + 4); }
                    const f32x4 r0 = x0 + g0 * acc[ai][bj][m][0], r1 = x1 + g1 * acc[ai][bj][m][1];
                    *(u32x4*)(xout + (size_t)row * ldo + c) = (u32x4){pk2(r0[0], r0[1]), pk2(r0[2], r0[3]), pk2(r1[0], r1[1]), pk2(r1[2], r1[3])};
                }
        }
    }
};
struct EpiG4 {
    static constexpr bool KEEP_ACC = false;
    bf16_t* actb;
    __device__ __forceinline__ void operator()(const f32x4 (&acc)[2][2][4][2], const Unit& u, int wr, int wc, int fr, int fq) const {
#pragma unroll
        for (int ai = 0; ai < 2; ++ai)
#pragma unroll
            for (int m = 0; m < 4; ++m) {
                const int row = u.pm * 256 + ai * 128 + wr * 64 + m * 16 + fr;
                const f32x4 g0 = acc[ai][0][m][0], g1 = acc[ai][0][m][1], u0 = acc[ai][1][m][0], u1 = acc[ai][1][m][1];
                float v[8];
#pragma unroll
                for (int j = 0; j < 4; ++j) { v[j] = siluf_(g0[j]) * u0[j]; v[4 + j] = siluf_(g1[j]) * u1[j]; }
                *(u32x4*)(actb + (size_t)row * FFH + u.pn * 128 + wc * 32 + 8 * fq) = (u32x4){pk2(v[0], v[1]), pk2(v[2], v[3]), pk2(v[4], v[5]), pk2(v[6], v[7])};
            }
    }
};

__device__ __forceinline__ void tr_tile(const float* __restrict__ src, const int ldsrc, const int c_lo, const int c_hi, const int k0, bf16_t* __restrict__ dst, const int K, const int n0, unsigned char* lds) {
    bf16_t* T = (bf16_t*)lds;
    const int tid = opaque_tid();
    f32x4 v[8];
#pragma unroll
    for (int i = 0; i < 8; ++i) {
        const int idx = tid + 512 * i, r = idx >> 6, c4 = idx & 63;
        v[i] = *(const f32x4*)(src + (size_t)(k0 + r) * ldsrc + (c4 < 32 ? c_lo + 4 * c4 : c_hi + 4 * (c4 - 32)));
    }
#pragma unroll
    for (int i = 0; i < 8; ++i) {
        const int idx = tid + 512 * i, r = idx >> 6, c4 = idx & 63;
        const unsigned p01 = pk2(v[i][0], v[i][1]), p23 = pk2(v[i][2], v[i][3]);
        T[(4 * c4 + 0) * 72 + r] = (bf16_t)(p01 & 0xffffu); T[(4 * c4 + 1) * 72 + r] = (bf16_t)(p01 >> 16);
        T[(4 * c4 + 2) * 72 + r] = (bf16_t)(p23 & 0xffffu); T[(4 * c4 + 3) * 72 + r] = (bf16_t)(p23 >> 16);
    }
    __syncthreads();
#pragma unroll
    for (int i = 0; i < 4; ++i) {
        const int idx = tid + 512 * i, n = idx >> 3, k8 = idx & 7;
        __builtin_nontemporal_store(*(const u32x4*)(T + n * 72 + 8 * k8), (u32x4*)(dst + (size_t)(n0 + n) * K + k0 + 8 * k8));
    }
    __syncthreads();
}

struct TrTile { const float* sp; size_t ldsrc; bf16_t* dst; int K; };
__device__ __forceinline__ TrTile tr_make(const float* src, int ldsrc, int c_lo, int c_hi, int k0, bf16_t* dst, int K, int n0, int tid) {
    const int n = tid & 255, kh = tid >> 8;
    TrTile t; t.sp = src + (size_t)(k0 + 32 * kh) * ldsrc + (n < 128 ? c_lo + n : c_hi + n - 128); t.ldsrc = (size_t)ldsrc; t.dst = dst + (size_t)n0 * K + k0; t.K = K; return t;
}
constexpr int LT_UP = 16 * 8, LT_O = 32 * 8, LT_FFI = 32 * 44, LT_FFO = 88 * 8, LT_TOTAL = 2 * LT_UP + LT_O + LT_FFI + LT_FFO;
__device__ __forceinline__ TrTile later_tile(const Params& p, int r, int tid) {
    if (r < LT_UP) { const int kt = r / 8, nt = r % 8; return tr_make(p.w_up_a, 2048, nt * 256, nt * 256 + 128, kt * 64, (bf16_t*)(p.ws + OFF_WT_UPA), 1024, nt * 256, tid); } r -= LT_UP;
    if (r < LT_UP) { const int kt = r / 8, nt = r % 8; return tr_make(p.w_up_b, 2048, nt * 256, nt * 256 + 128, kt * 64, (bf16_t*)(p.ws + OFF_WT_UPB), 1024, nt * 256, tid); } r -= LT_UP;
    if (r < LT_O) { const int kt = r / 8, nt = r % 8; return tr_make(p.w_o, 2048, nt * 256, nt * 256 + 128, kt * 64, (bf16_t*)(p.ws + OFF_WT_O), 2048, nt * 256, tid); } r -= LT_O;
    if (r < LT_FFI) { const int kt = r / 44, nt = r % 44; return tr_make(p.w_ffn_in, 2 * FFH, 128 * nt, FFH + 128 * nt, kt * 64, (bf16_t*)(p.ws + OFF_WT_FFI), 2048, nt * 256, tid); } r -= LT_FFI;
    { const int kt = r / 8, nt = r % 8; return tr_make(p.w_ffn_out, 2048, nt * 256, nt * 256 + 128, kt * 64, (bf16_t*)(p.ws + OFF_WT_FFO), FFH, nt * 256, tid); }
}
__device__ __forceinline__ void tr_load(const TrTile& t, float (&v)[32]) {
#pragma unroll
    for (int i = 0; i < 32; ++i) v[i] = t.sp[(size_t)i * t.ldsrc];
}
__device__ __forceinline__ void tr_to_lds(bf16_t* T, const float (&v)[32], int tid) {
    const int n = tid & 255, kh = tid >> 8;
#pragma unroll
    for (int q = 0; q < 8; ++q) *(u32x2*)(T + n * 68 + 32 * kh + 4 * q) = (u32x2){pk2(v[4 * q], v[4 * q + 1]), pk2(v[4 * q + 2], v[4 * q + 3])};
}
__device__ __forceinline__ void tr_store(const bf16_t* T, const TrTile& t, int tid) {
#pragma unroll
    for (int i = 0; i < 4; ++i) {
        const int idx = tid + 512 * i, nn = idx >> 3, k8 = idx & 7;
        const u32x2 lo = *(const u32x2*)(T + nn * 68 + 8 * k8), hi = *(const u32x2*)(T + nn * 68 + 8 * k8 + 4);
        __builtin_nontemporal_store((u32x4){lo[0], lo[1], hi[0], hi[1]}, (u32x4*)(t.dst + (size_t)nn * t.K + 8 * k8));
    }
}
__device__ __forceinline__ void mod_job(const Params& p, const int job, unsigned char* lds) {
    float* sc = (float*)lds;
    float* red = (float*)(lds + 65536);
    const int tid = opaque_tid(), lane = tid & 63, wave = tid >> 6;
    for (int i = tid; i < 8 * 2048; i += 512) sc[i] = siluf_(p.c[i]);
    __syncthreads();
    const int cg4 = lane & 15, ks = wave * 4 + (lane >> 4);
    const int col = job * 64 + cg4 * 4;
    f32x4 acc[8];
#pragma unroll
    for (int b = 0; b < 8; ++b) acc[b] = (f32x4){0.f, 0.f, 0.f, 0.f};
    const float* wp = p.w_ada + (size_t)(ks * 64) * NMOD + col;
#pragma unroll 8
    for (int kk = 0; kk < 64; ++kk) {
        const f32x4 w = *(const f32x4*)(wp + (size_t)kk * NMOD);
        const int k = ks * 64 + kk;
#pragma unroll
        for (int b = 0; b < 8; ++b) acc[b] += w * sc[b * 2048 + k];
    }
#pragma unroll
    for (int b = 0; b < 8; ++b)
#pragma unroll
        for (int j = 0; j < 4; ++j) { float v = acc[b][j]; v += __shfl_xor(v, 16); v += __shfl_xor(v, 32); if (lane < 16) red[(wave * 8 + b) * 64 + cg4 * 4 + j] = v; }
    __syncthreads();
    { const int b = tid >> 6, cc = tid & 63; float s = 0.f;
#pragma unroll
      for (int w = 0; w < 8; ++w) s += red[(w * 8 + b) * 64 + cc];
      ((float*)(p.ws + OFF_MOD))[b * NMOD + job * 64 + cc] = s + p.b_ada[job * 64 + cc]; }
    __syncthreads();
}
__device__ __forceinline__ void phase_prep(const Params& p, unsigned char* lds) {
    constexpr int NMODJ = 192, T_IN = 32 * 44, NJOBS = NMODJ + T_IN;
    {   u32x4* g = (u32x4*)(p.ws + OFF_GRAN);
        for (size_t i = (size_t)blockIdx.x * 512 + threadIdx.x; i < GRAN_BYTES / 16; i += (size_t)gridDim.x * 512) g[i] = (u32x4){0u, 0u, 0u, 0u}; }
    for (int j = blockIdx.x; j < NJOBS; j += gridDim.x) {
        int r = j;
        if (r < NMODJ) { mod_job(p, r, lds); continue; } r -= NMODJ;
        { const int kt = r / 44, nt = r % 44, n0 = nt * 256, c0 = n0 < 7168 ? n0 : n0 + 16; tr_tile(p.w_in, INW, c0, c0 + 128, kt * 64, (bf16_t*)(p.ws + OFF_WT_IN), 2048, n0, lds); }
    }
}

__device__ __forceinline__ void phase_h(const Params& p, unsigned char* lds) {
    bf16_t* wg = (bf16_t*)lds;
    const int tid = opaque_tid(), lane = tid & 63, wave = tid >> 6;
    for (int i = tid; i < 8192; i += 512) { const int k = i >> 2, q = i & 3; const f32x4 v = *(const f32x4*)(p.w_in + (size_t)k * INW + 7168 + 4 * q);
        *(u32x2*)(wg + k * 16 + 4 * q) = (u32x2){pk2(v[0], v[1]), pk2(v[2], v[3])}; }
    float* wk2 = (float*)(lds + 65536);
    for (int i = tid; i < 2048; i += 512) *(f32x4*)(wk2 + 4 * i) = *(const f32x4*)(p.w_gk2 + 4 * i);
    __syncthreads();
    const f32x4 bk0 = *(const f32x4*)(p.b_gk2 + 8 * lane), bk1 = *(const f32x4*)(p.b_gk2 + 8 * lane + 4);
    const float* MOD = (const float*)(p.ws + OFF_MOD); bf16_t* H = (bf16_t*)p.out; bf16_t* GDEC = (bf16_t*)(p.ws + OFF_GDEC);
    const int rstep = gridDim.x * 8;
    for (int row = blockIdx.x * 8 + wave; row < NTOK; row += rstep) {
        const int b = row >> 11;
        f32x4 xv[8];
#pragma unroll
        for (int i = 0; i < 8; ++i) xv[i] = *(const f32x4*)(p.x + (size_t)row * DM + i * 256 + lane * 4);
        const int rnext = row + rstep < NTOK ? row + rstep : row;
        const float pf = p.x[(size_t)rnext * DM + lane * 32];
        float ss = 0.f;
#pragma unroll
        for (int i = 0; i < 8; ++i) ss += xv[i][0] * xv[i][0] + xv[i][1] * xv[i][1] + xv[i][2] * xv[i][2] + xv[i][3] * xv[i][3];
        ss = wave_sum(ss);
        const float rstd = rsqrtf(ss * (1.f / 2048.f) + EPS);
        float part[16];
#pragma unroll
        for (int n = 0; n < 16; ++n) part[n] = 0.f;
#pragma unroll
        for (int i = 0; i < 8; ++i) {
            const int col = i * 256 + lane * 4;
            const f32x4 w = *(const f32x4*)(p.norm1_w + col), sc = *(const f32x4*)(MOD + (size_t)b * NMOD + 2048 + col), sh = *(const f32x4*)(MOD + (size_t)b * NMOD + col);
            f32x4 hv;
#pragma unroll
            for (int j = 0; j < 4; ++j) hv[j] = xv[i][j] * rstd * w[j] * (1.f + sc[j]) + sh[j];
            __builtin_nontemporal_store((u32x2){pk2(hv[0], hv[1]), pk2(hv[2], hv[3])}, (u32x2*)(H + (size_t)row * DM + col));
#pragma unroll
            for (int j = 0; j < 4; ++j) {
                const u32x4 w0 = *(const u32x4*)(wg + (col + j) * 16), w1 = *(const u32x4*)(wg + (col + j) * 16 + 8);
#pragma unroll
                for (int q = 0; q < 4; ++q) { part[2 * q] += hv[j] * bflo(w0[q]); part[2 * q + 1] += hv[j] * bfhi(w0[q]); part[8 + 2 * q] += hv[j] * bflo(w1[q]); part[9 + 2 * q] += hv[j] * bfhi(w1[q]); }
            }
            __builtin_amdgcn_sched_barrier(0);
        }
#pragma unroll
        for (int n = 0; n < 16; ++n) part[n] = wave_sum(part[n]);
        {
            f32x4 z0 = bk0, z1 = bk1;
#pragma unroll
            for (int r = 0; r < 16; ++r) { const f32x4 wa = *(const f32x4*)(wk2 + r * 512 + 8 * lane), wb = *(const f32x4*)(wk2 + r * 512 + 8 * lane + 4); z0 += wa * part[r]; z1 += wb * part[r]; }
            float g[8];
#pragma unroll
            for (int j = 0; j < 4; ++j) { g[j] = -0.0625f * 0.6931471805599453f * __log2f(1.f + __expf(-z0[j])); g[4 + j] = -0.0625f * 0.6931471805599453f * __log2f(1.f + __expf(-z1[j])); }
            *(u32x4*)(GDEC + (size_t)row * 512 + 8 * lane) = (u32x4){pk2(g[0], g[1]), pk2(g[2], g[3]), pk2(g[4], g[5]), pk2(g[6], g[7])};
        }
        asm volatile("" :: "v"(pf));
    }
}

constexpr int RP = 136;
constexpr int VP = 72;
constexpr int OBP = 68;
__device__ __forceinline__ bf16x8 mk8(unsigned a, unsigned b, unsigned c, unsigned d) { return __builtin_bit_cast(bf16x8, (u32x4){a, b, c, d}); }

template <bool IS_A>
__device__ __forceinline__ void rec_finish(unsigned long long* GR, unsigned long long (&sg)[4], const int sib0, const int item, const int chunk, const int vj, const float ss_own,
                                           const f32x4 o0, const f32x4 o1, const f32x4 nw0, const f32x4 nw1, const u32x4 gate, bf16_t* dstp) {
    float total = ss_own;
#pragma unroll
    for (int k = 0; k < (IS_A ? 2 : 4); ++k) {
        if (sib0 + k == item) continue;
        unsigned long long x = sg[k];
        for (unsigned spins = 0; (unsigned)(x >> 32) != (unsigned)(chunk + 1) && spins < (1u << 22); ++spins) { __builtin_amdgcn_s_sleep(1); x = __hip_atomic_load(GR + ((size_t)(sib0 + k) * 32 + chunk) * 64 + vj, __ATOMIC_RELAXED, __HIP_MEMORY_SCOPE_AGENT); }
        total += __uint_as_float((unsigned)x);
    }
    const float rs = rsqrtf(total * (IS_A ? (1.f / 128.f) : (1.f / 256.f)) + EPS);
    const float g[8] = {bflo(gate[0]), bfhi(gate[0]), bflo(gate[1]), bfhi(gate[1]), bflo(gate[2]), bfhi(gate[2]), bflo(gate[3]), bfhi(gate[3])};
    float y[8];
#pragma unroll
    for (int j = 0; j < 4; ++j) { y[j] = o0[j] * rs * nw0[j] * siluf_(g[j]); y[4 + j] = o1[j] * rs * nw1[j] * siluf_(g[4 + j]); }
    __builtin_nontemporal_store((u32x4){pk2(y[0], y[1]), pk2(y[2], y[3]), pk2(y[4], y[5]), pk2(y[6], y[7])}, (u32x4*)dstp);
}
template <bool IS_A>
__device__ __forceinline__ void rec_item2(const Params& p, unsigned char* lds, const int item, const int b, const int h, const int es, const bool side_on, const int side_first, const int side_stride) {
    bf16_t* QL = (bf16_t*)lds; bf16_t* KD = QL + 64 * RP; bf16_t* KE = KD + 64 * RP; bf16_t* QI = KE + 64 * RP; bf16_t* XB = QI + 64 * RP;
    bf16_t* KDT = XB + 48 * RP;
    bf16_t* VT = KDT + 128 * VP;
    bf16_t* AT = VT + 64 * VP;
    float* T8 = (float*)(AT + 64 * VP);
    float* EB = T8 + 1024;
    float* GKl = EB + 128;
    float* OB = (float*)lds;
    bf16_t* TT = (bf16_t*)(lds + 128256);
    const int tid = opaque_tid(), lane = tid & 63, wave = __builtin_amdgcn_readfirstlane(tid >> 6), fr = lane & 15, fq = lane >> 4, dh = wave >> 2, eb = wave & 3;
    const bf16_t* PREC = (const bf16_t*)(p.ws + OFF_PREC);
    const bf16_t* GDEC = (const bf16_t*)(p.ws + OFF_GDEC);
    bf16_t* Y = (bf16_t*)p.out;
    unsigned long long* GR = (unsigned long long*)(p.ws + OFF_GRAN);
    const int sib0 = IS_A ? (item & ~1) : 128 + ((item - 128) & ~3);
    const int gcol = IS_A ? 3072 + h * 128 + es * 64 : 6144 + h * 256 + es * 64;
    const int qcol = IS_A ? h * 128 : 4096 + h * 128;
    const int kcol = IS_A ? 1024 + h * 128 : 4608 + h * 128;
    const int vcol = IS_A ? 2048 + h * 128 + es * 64 : 5120 + h * 256 + es * 64;
    const int ocol = IS_A ? h * 128 + es * 64 : 1024 + h * 256 + es * 64;
    const int d0 = 2 * lane, r0 = 8 * wave, sub = wave >> 1;
    const int vj = tid >> 3, ve8 = (tid & 7) * 8;
    const f32x4 nw0 = *(const f32x4*)((IS_A ? p.a_norm_w : p.b_norm_w) + es * 64 + ve8), nw1 = *(const f32x4*)((IS_A ? p.a_norm_w : p.b_norm_w) + es * 64 + ve8 + 4);
    const size_t row0 = (size_t)b * 2048;
    float lb0 = 0.f, lb1 = 0.f;
    if (IS_A) { const int ch = h * 128 + d0; lb0 = 1.f / (1.f + __expf(p.lb_param[1024 + ch] - p.lb_param[ch])); lb1 = 1.f / (1.f + __expf(p.lb_param[1025 + ch] - p.lb_param[ch + 1])); }
    f32x4 S[4];
#pragma unroll
    for (int i = 0; i < 4; ++i) S[i] = (f32x4){0.f, 0.f, 0.f, 0.f};
    for (int i = tid; i < 64 * VP / 2; i += 512) ((unsigned*)AT)[i] = 0u;
    unsigned qraw[8], kraw[8], graw[8]; u32x4 vraw;
#pragma unroll
    for (int r = 0; r < 8; ++r) { const bf16_t* pr = PREC + (row0 + r0 + r) * PREC_W; qraw[r] = *(const unsigned*)(pr + qcol + d0); kraw[r] = *(const unsigned*)(pr + kcol + d0);
        graw[r] = IS_A ? 0u : *(const unsigned*)(GDEC + (row0 + r0 + r) * 512 + h * 128 + d0); }
    vraw = *(const u32x4*)(PREC + (row0 + vj) * PREC_W + vcol + ve8);
    u32x4 gate_cur = *(const u32x4*)(PREC + (row0 + vj) * PREC_W + gcol + ve8), gate_nxt = gate_cur, gate_prev = gate_cur;
    f32x4 op0 = (f32x4){0.f, 0.f, 0.f, 0.f}, op1 = op0; float ss_prev = 0.f;
    unsigned long long sg[4] = {0ull, 0ull, 0ull, 0ull};
    __syncthreads();
    float sv[32]; TrTile stile; bool s_have = false;
    stile.sp = nullptr; stile.ldsrc = 0; stile.dst = nullptr; stile.K = 0;
#pragma unroll
    for (int i = 0; i < 32; ++i) sv[i] = 0.f;
    for (int c = 0; c < 32; ++c) {
        float q0[8], q1[8], k0[8], k1[8], P0[8], P1[8];
#pragma unroll
        for (int r = 0; r < 8; ++r) {
            q0[r] = bflo(qraw[r]); q1[r] = bfhi(qraw[r]);
            float a0, a1;
            if (IS_A) { a0 = lb0 + (1.f - lb0) * sigmoidf_(bflo(kraw[r])); a1 = lb1 + (1.f - lb1) * sigmoidf_(bfhi(kraw[r])); k0[r] = 1.f - a0; k1[r] = 1.f - a1; }
            else { a0 = __expf(bflo(graw[r])); a1 = __expf(bfhi(graw[r])); k0[r] = bflo(kraw[r]); k1[r] = bfhi(kraw[r]); }
            P0[r] = r ? P0[r - 1] * a0 : a0; P1[r] = r ? P1[r - 1] * a1 : a1;
        }
        *(float2*)(T8 + wave * 128 + d0) = make_float2(P0[7], P1[7]);
        __syncthreads();
        float T0[4], T1[4];
#pragma unroll
        for (int s = 0; s < 4; ++s) { const float2 x = *(const float2*)(T8 + (2 * s) * 128 + d0), y = *(const float2*)(T8 + (2 * s + 1) * 128 + d0); T0[s] = x.x * y.x; T1[s] = x.y * y.y; }
        float pre0 = 1.f, pre1 = 1.f;
        if (wave & 1) { const float2 x = *(const float2*)(T8 + (wave - 1) * 128 + d0); pre0 = x.x; pre1 = x.y; }
        float R0 = 1.f, R1 = 1.f, U0 = 1.f, U1 = 1.f, Ts0 = 1.f, Ts1 = 1.f;
#pragma unroll
        for (int s = 0; s < 4; ++s) { if (s < sub) { R0 *= T0[s]; R1 *= T1[s]; } if (s > sub) { U0 *= T0[s]; U1 *= T1[s]; } if (s == sub) { Ts0 = T0[s]; Ts1 = T1[s]; } }
        if (wave == 0) *(float2*)(EB + d0) = make_float2(T0[0] * T0[1] * T0[2] * T0[3], T1[0] * T1[1] * T1[2] * T1[3]);
        unsigned kdc0[4], kdc1[4];
        float kprev0 = 0.f, kprev1 = 0.f;
#pragma unroll
        for (int r = 0; r < 8; ++r) {
            const int i = r0 + r;
            const float pl0 = pre0 * P0[r], pl1 = pre1 * P1[r];
            const float iv0 = __builtin_amdgcn_rcpf(pl0), iv1 = __builtin_amdgcn_rcpf(pl1);
            const float ql0 = q0[r] * pl0, ql1 = q1[r] * pl1;
            const float kd0 = k0[r] * iv0, kd1 = k1[r] * iv1;
            const float ke0 = kd0 * Ts0, ke1 = kd1 * Ts1;
            *(unsigned*)(QL + i * RP + d0) = pk2(ql0, ql1);
            *(unsigned*)(QI + i * RP + d0) = pk2(ql0 * R0, ql1 * R1);
            *(unsigned*)(KD + i * RP + d0) = pk2(kd0, kd1);
            *(unsigned*)(KE + i * RP + d0) = pk2(ke0, ke1);
            if (sub == 2) *(unsigned*)(XB + (i - 32) * RP + d0) = pk2(ql0 * T0[1], ql1 * T1[1]);
            if (sub == 3) { *(unsigned*)(XB + (16 + i - 48) * RP + d0) = pk2(ql0 * T0[2], ql1 * T1[2]); *(unsigned*)(XB + (32 + i - 48) * RP + d0) = pk2(ql0 * (T0[1] * T0[2]), ql1 * (T1[1] * T1[2])); }
            const float kc0 = ke0 * U0, kc1 = ke1 * U1;
            if (r & 1) { kdc0[r >> 1] = pk2(kprev0, kc0); kdc1[r >> 1] = pk2(kprev1, kc1); } else { kprev0 = kc0; kprev1 = kc1; }
        }
        *(u32x4*)(KDT + d0 * VP + r0) = (u32x4){kdc0[0], kdc0[1], kdc0[2], kdc0[3]};
        *(u32x4*)(KDT + (d0 + 1) * VP + r0) = (u32x4){kdc1[0], kdc1[1], kdc1[2], kdc1[3]};
#pragma unroll
        for (int q = 0; q < 4; ++q) { VT[(ve8 + 2 * q) * VP + vj] = (bf16_t)(vraw[q] & 0xffffu); VT[(ve8 + 2 * q + 1) * VP + vj] = (bf16_t)(vraw[q] >> 16); }
        if (s_have) tr_to_lds(TT, sv, tid);
        const bool s_store = s_have; const TrTile s_prev = stile;
        {   const int lt = side_first + c * side_stride;
            s_have = side_on && lt < LT_TOTAL;
            if (s_have) { stile = later_tile(p, lt, tid); tr_load(stile, sv); } }
        if (c + 1 < 32) {
            const size_t rn = row0 + (size_t)(c + 1) * 64;
#pragma unroll
            for (int r = 0; r < 8; ++r) { const bf16_t* pr = PREC + (rn + r0 + r) * PREC_W; qraw[r] = *(const unsigned*)(pr + qcol + d0); kraw[r] = *(const unsigned*)(pr + kcol + d0);
                if (!IS_A) graw[r] = *(const unsigned*)(GDEC + (rn + r0 + r) * 512 + h * 128 + d0); }
            vraw = *(const u32x4*)(PREC + (rn + vj) * PREC_W + vcol + ve8);
            gate_nxt = *(const u32x4*)(PREC + (rn + vj) * PREC_W + gcol + ve8);
        }
        __syncthreads();
        if (s_store) tr_store(TT, s_prev, tid);
        if (c > 0) {
#pragma unroll
            for (int k = 0; k < (IS_A ? 2 : 4); ++k) sg[k] = __hip_atomic_load(GR + ((size_t)(sib0 + k) * 32 + (c - 1)) * 64 + vj, __ATOMIC_RELAXED, __HIP_MEMORY_SCOPE_AGENT); }
        f32x4 op[4];
#pragma unroll
        for (int ib = 0; ib < 4; ++ib) op[ib] = (f32x4){0.f, 0.f, 0.f, 0.f};
#pragma unroll
        for (int ks = 0; ks < 2; ++ks) {
            const bf16x8 Bs = mk8(pk2(S[2 * ks][0], S[2 * ks][1]), pk2(S[2 * ks][2], S[2 * ks][3]), pk2(S[2 * ks + 1][0], S[2 * ks + 1][1]), pk2(S[2 * ks + 1][2], S[2 * ks + 1][3]));
#pragma unroll
            for (int ib = 0; ib < 4; ++ib) {
                const bf16_t* qa = QI + (16 * ib + fr) * RP + 64 * dh + 32 * ks + 4 * fq;
                const u32x2 lo = *(const u32x2*)qa, hi = *(const u32x2*)(qa + 16);
                op[ib] = __builtin_amdgcn_mfma_f32_16x16x32_bf16(mk8(lo[0], lo[1], hi[0], hi[1]), Bs, op[ib], 0, 0, 0);
            }
        }
        for (int bi = wave; bi < 10; bi += 8) {
            const int s = bi >= 6 ? 3 : (bi >= 3 ? 2 : (bi >= 1 ? 1 : 0)), r = bi - (s * (s + 1)) / 2, diff = s - r;
            const bf16_t *Ab, *Bb;
            if (diff == 0) { Ab = QL + 16 * s * RP; Bb = KD + 16 * r * RP; }
            else if (diff == 1) { Ab = QL + 16 * s * RP; Bb = KE + 16 * r * RP; }
            else if (diff == 2) { Ab = XB + (s == 2 ? 0 : 16) * RP; Bb = KE + 16 * r * RP; }
            else { Ab = XB + 32 * RP; Bb = KE; }
            f32x4 at = (f32x4){0.f, 0.f, 0.f, 0.f};
#pragma unroll
            for (int ks = 0; ks < 4; ++ks) {
                const bf16x8 av = *(const bf16x8*)(Ab + fr * RP + 32 * ks + 8 * fq), bv = *(const bf16x8*)(Bb + fr * RP + 32 * ks + 8 * fq);
                at = __builtin_amdgcn_mfma_f32_16x16x32_bf16(av, bv, at, 0, 0, 0);
            }
#pragma unroll
            for (int jj = 0; jj < 4; ++jj) { float v = at[jj]; if (diff == 0 && fr > 4 * fq + jj) v = 0.f; AT[(16 * s + 4 * fq + jj) * VP + 16 * r + fr] = (bf16_t)(pk2(v, 0.f) & 0xffffu); }
        }
        __syncthreads();
        {   const bf16x8 bv = *(const bf16x8*)(VT + (16 * eb + fr) * VP + 32 * dh + 8 * fq);
#pragma unroll
            for (int ib = 0; ib < 4; ++ib) {
                if (dh == 1 && ib < 2) continue;
                const bf16x8 av = *(const bf16x8*)(AT + (16 * ib + fr) * VP + 32 * dh + 8 * fq);
                op[ib] = __builtin_amdgcn_mfma_f32_16x16x32_bf16(av, bv, op[ib], 0, 0, 0);
            }
        }
#pragma unroll
        for (int ib = 0; ib < 4; ++ib)
#pragma unroll
            for (int jj = 0; jj < 4; ++jj) OB[(dh * 64 + 16 * ib + 4 * fq + jj) * OBP + 16 * eb + fr] = op[ib][jj];
#pragma unroll
        for (int dt = 0; dt < 4; ++dt) {
            const f32x4 ebv = *(const f32x4*)(EB + 64 * dh + 16 * dt + 4 * fq);
            S[dt] = S[dt] * ebv;
#pragma unroll
            for (int ks = 0; ks < 2; ++ks) {
                const bf16x8 av = *(const bf16x8*)(KDT + (64 * dh + 16 * dt + fr) * VP + 32 * ks + 8 * fq), bv = *(const bf16x8*)(VT + (16 * eb + fr) * VP + 32 * ks + 8 * fq);
                S[dt] = __builtin_amdgcn_mfma_f32_16x16x32_bf16(av, bv, S[dt], 0, 0, 0);
            }
        }
        __syncthreads();
        {   const float* o0 = OB + vj * OBP + ve8; const float* o1 = OB + (64 + vj) * OBP + ve8;
            const f32x4 a0 = *(const f32x4*)o0 + *(const f32x4*)o1, a1 = *(const f32x4*)(o0 + 4) + *(const f32x4*)(o1 + 4);
            float ss = a0[0] * a0[0] + a0[1] * a0[1] + a0[2] * a0[2] + a0[3] * a0[3] + a1[0] * a1[0] + a1[1] * a1[1] + a1[2] * a1[2] + a1[3] * a1[3];
            ss += __shfl_xor(ss, 1); ss += __shfl_xor(ss, 2); ss += __shfl_xor(ss, 4);
            if ((tid & 7) == 0) __hip_atomic_store(GR + ((size_t)item * 32 + c) * 64 + vj, ((unsigned long long)(unsigned)(c + 1) << 32) | (unsigned long long)__float_as_uint(ss), __ATOMIC_RELAXED, __HIP_MEMORY_SCOPE_AGENT);
            if (c > 0) rec_finish<IS_A>(GR, sg, sib0, item, c - 1, vj, ss_prev, op0, op1, nw0, nw1, gate_prev, Y + (row0 + (size_t)(c - 1) * 64 + vj) * DM + ocol + ve8);
            op0 = a0; op1 = a1; ss_prev = ss; gate_prev = gate_cur; gate_cur = gate_nxt;
        }
        __syncthreads();
    }
    {
#pragma unroll
        for (int k = 0; k < (IS_A ? 2 : 4); ++k) sg[k] = __hip_atomic_load(GR + ((size_t)(sib0 + k) * 32 + 31) * 64 + vj, __ATOMIC_RELAXED, __HIP_MEMORY_SCOPE_AGENT);
        rec_finish<IS_A>(GR, sg, sib0, item, 31, vj, ss_prev, op0, op1, nw0, nw1, gate_prev, Y + (row0 + (size_t)31 * 64 + vj) * DM + ocol + ve8);
    }
    if (s_have) { tr_to_lds(TT, sv, tid); __syncthreads(); tr_store(TT, stile, tid); __syncthreads(); }
}
__device__ __forceinline__ void phase_rec2(const Params& p, unsigned char* lds) {
    int nitem = 0;
    for (int item = blockIdx.x; item < 256; item += gridDim.x, ++nitem) {
        if (item < 128) { const int seq = item >> 1; rec_item2<true>(p, lds, item, seq >> 3, seq & 7, item & 1, nitem == 0, (int)blockIdx.x, (int)gridDim.x); }
        else { const int w = item - 128, seq = w >> 2; rec_item2<false>(p, lds, item, seq >> 2, seq & 3, w & 3, nitem == 0, (int)blockIdx.x, (int)gridDim.x); }
    }
    const int tid = opaque_tid();
    for (int lt = (nitem ? (int)blockIdx.x + 32 * (int)gridDim.x : (int)blockIdx.x); lt < LT_TOTAL; lt += gridDim.x) {
        float v[32]; const TrTile t = later_tile(p, lt, tid); tr_load(t, v); tr_to_lds((bf16_t*)(lds + 128256), v, tid); __syncthreads(); tr_store((const bf16_t*)(lds + 128256), t, tid); __syncthreads();
    }
}

__device__ __forceinline__ void phase_y(const Params& p) {
    const int tid = opaque_tid(), lane = tid & 63, wave = tid >> 6;
    const bf16_t* PREC = (const bf16_t*)(p.ws + OFF_PREC);
    const bf16_t* O = (const bf16_t*)p.out + (size_t)NTOK * DM; bf16_t* Y = (bf16_t*)p.out;
    const int rstep = gridDim.x * 8;
    int row = blockIdx.x * 8 + wave;
    u32x4 ov[4], gv[4], on[4], gn[4];
    if (row < NTOK) {
#pragma unroll
        for (int i = 0; i < 4; ++i) { const int col = 512 * i + 8 * lane; ov[i] = *(const u32x4*)(O + (size_t)row * DM + col); gv[i] = *(const u32x4*)(PREC + (size_t)row * PREC_W + (i < 2 ? 3072 + col : 6144 + col - 1024)); }
    }
    for (; row < NTOK; row += rstep) {
        const int rnext = row + rstep < NTOK ? row + rstep : row;
#pragma unroll
        for (int i = 0; i < 4; ++i) { const int col = 512 * i + 8 * lane; on[i] = *(const u32x4*)(O + (size_t)rnext * DM + col); gn[i] = *(const u32x4*)(PREC + (size_t)rnext * PREC_W + (i < 2 ? 3072 + col : 6144 + col - 1024)); }
#pragma unroll
        for (int i = 0; i < 4; ++i) {
            const int col = 512 * i + 8 * lane;
            float o[8] = {bflo(ov[i][0]), bfhi(ov[i][0]), bflo(ov[i][1]), bfhi(ov[i][1]), bflo(ov[i][2]), bfhi(ov[i][2]), bflo(ov[i][3]), bfhi(ov[i][3])};
            float ss = 0.f;
#pragma unroll
            for (int j = 0; j < 8; ++j) ss += o[j] * o[j];
            ss += __shfl_xor(ss, 1); ss += __shfl_xor(ss, 2); ss += __shfl_xor(ss, 4); ss += __shfl_xor(ss, 8);
            float rs; const float* nw;
            if (i < 2) { rs = rsqrtf(ss * (1.f / 128.f) + EPS); nw = p.a_norm_w + (col & 127); }
            else { ss += __shfl_xor(ss, 16); rs = rsqrtf(ss * (1.f / 256.f) + EPS); nw = p.b_norm_w + ((col - 1024) & 255); }
            const f32x4 w0 = *(const f32x4*)nw, w1 = *(const f32x4*)(nw + 4);
            const float g[8] = {bflo(gv[i][0]), bfhi(gv[i][0]), bflo(gv[i][1]), bfhi(gv[i][1]), bflo(gv[i][2]), bfhi(gv[i][2]), bflo(gv[i][3]), bfhi(gv[i][3])};
            float y[8];
#pragma unroll
            for (int j = 0; j < 4; ++j) { y[j] = o[j] * rs * w0[j] * siluf_(g[j]); y[4 + j] = o[4 + j] * rs * w1[j] * siluf_(g[4 + j]); }
            __builtin_nontemporal_store((u32x4){pk2(y[0], y[1]), pk2(y[2], y[3]), pk2(y[4], y[5]), pk2(y[6], y[7])}, (u32x4*)(Y + (size_t)row * DM + col));
        }
#pragma unroll
        for (int i = 0; i < 4; ++i) { ov[i] = on[i]; gv[i] = gn[i]; }
    }
}

__device__ __forceinline__ void phase_h2(const Params& p) {
    const int tid = opaque_tid(), lane = tid & 63, wave = tid >> 6;
    const float* MOD = (const float*)(p.ws + OFF_MOD); bf16_t* H2 = (bf16_t*)p.out; const bf16_t* X1 = (const bf16_t*)(p.ws + OFF_PM);
    const int rstep = gridDim.x * 8;
    int row = blockIdx.x * 8 + wave;
    u32x2 xv[8], xn[8];
    if (row < NTOK) {
#pragma unroll
        for (int i = 0; i < 8; ++i) xv[i] = *(const u32x2*)(X1 + (size_t)row * MP + i * 256 + lane * 4);
    }
    for (; row < NTOK; row += rstep) {
        const int b = row >> 11;
        const int rnext = row + rstep < NTOK ? row + rstep : row;
#pragma unroll
        for (int i = 0; i < 8; ++i) xn[i] = *(const u32x2*)(X1 + (size_t)rnext * MP + i * 256 + lane * 4);
        f32x4 x[8]; float ss = 0.f;
#pragma unroll
        for (int i = 0; i < 8; ++i) { x[i] = (f32x4){bflo(xv[i][0]), bfhi(xv[i][0]), bflo(xv[i][1]), bfhi(xv[i][1])}; ss += x[i][0] * x[i][0] + x[i][1] * x[i][1] + x[i][2] * x[i][2] + x[i][3] * x[i][3]; }
        ss = wave_sum(ss);
        const float rstd = rsqrtf(ss * (1.f / 2048.f) + EPS);
#pragma unroll
        for (int i = 0; i < 8; ++i) {
            const int col = i * 256 + lane * 4;
            const f32x4 w = *(const f32x4*)(p.norm2_w + col), sc = *(const f32x4*)(MOD + (size_t)b * NMOD + 8192 + col), sh = *(const f32x4*)(MOD + (size_t)b * NMOD + 6144 + col);
            f32x4 hv;
#pragma unroll
            for (int j = 0; j < 4; ++j) hv[j] = x[i][j] * rstd * w[j] * (1.f + sc[j]) + sh[j];
            __builtin_nontemporal_store((u32x2){pk2(hv[0], hv[1]), pk2(hv[2], hv[3])}, (u32x2*)(H2 + (size_t)row * DM + col));
        }
#pragma unroll
        for (int i = 0; i < 8; ++i) xv[i] = xn[i];
    }
}
__device__ __forceinline__ void phase_final(const Params& p) {
    const int tid = opaque_tid(), lane = tid & 63, wave = tid >> 6;
    const bf16_t* X2 = (const bf16_t*)(p.ws + OFF_PM);
    const int rstep = gridDim.x * 8;
    int row = blockIdx.x * 8 + wave;
    u32x2 xv[8], xn[8];
    if (row < NTOK) {
#pragma unroll
        for (int i = 0; i < 8; ++i) xv[i] = *(const u32x2*)(X2 + (size_t)row * MP + i * 256 + lane * 4);
    }
    for (; row < NTOK; row += rstep) {
        const int rnext = row + rstep < NTOK ? row + rstep : row;
#pragma unroll
        for (int i = 0; i < 8; ++i) xn[i] = *(const u32x2*)(X2 + (size_t)rnext * MP + i * 256 + lane * 4);
        f32x4 x[8]; float ss = 0.f;
#pragma unroll
        for (int i = 0; i < 8; ++i) { x[i] = (f32x4){bflo(xv[i][0]), bfhi(xv[i][0]), bflo(xv[i][1]), bfhi(xv[i][1])}; ss += x[i][0] * x[i][0] + x[i][1] * x[i][1] + x[i][2] * x[i][2] + x[i][3] * x[i][3]; }
        ss = wave_sum(ss);
        const float rstd = rsqrtf(ss * (1.f / 2048.f) + EPS);
        float* xr = p.out + (size_t)row * DM;
#pragma unroll
        for (int i = 0; i < 8; ++i) {
            const int col = i * 256 + lane * 4;
            const f32x4 w = *(const f32x4*)(p.final_norm_w + col);
            __builtin_nontemporal_store(x[i] * rstd * w, (f32x4*)(xr + col));
        }
#pragma unroll
        for (int i = 0; i < 8; ++i) xv[i] = xn[i];
    }
}

#define XB_TMO      128
#define XB_XCNT(j)  (256  + 64 * (j))
#define XB_XSUB(j)  (1280 + 64 * (j))
#define XB_XGEN(j)  (2304 + 64 * (j))
#define XB_TOP      3328
#define XB_TOPGEN   3392
#define XCD_BAR_WORDS 3456
#define XB_SPIN_CAP (1u << 20)
__device__ __forceinline__ unsigned xb_ld(unsigned* p)              { return __hip_atomic_load(p, __ATOMIC_RELAXED, __HIP_MEMORY_SCOPE_AGENT); }
__device__ __forceinline__ unsigned xb_add(unsigned* p, unsigned v) { return __hip_atomic_fetch_add(p, v, __ATOMIC_RELAXED, __HIP_MEMORY_SCOPE_AGENT); }
__device__ __forceinline__ unsigned xb_xcc_id() { return (unsigned)__builtin_amdgcn_s_getreg((3 << 11) | 20) & 0xFu; }
#define XB_SPIN(cond, bar) do { unsigned _sp = 0; while (cond) { __builtin_amdgcn_s_sleep(1); \
    if ((++_sp & 255u) == 0u) { if (xb_ld(&(bar)[XB_TMO])) break; if (_sp > XB_SPIN_CAP) { atomicAdd(&(bar)[XB_TMO], 1u); break; } } } } while (0)
struct XcdBarrier { unsigned* bar; unsigned x; volatile LAS unsigned* st; };
__device__ __forceinline__ XcdBarrier xcd_barrier_post(unsigned* bar, volatile LAS unsigned* st) {
    XcdBarrier b; b.bar = bar; b.x = xb_xcc_id(); b.st = st;
    if (threadIdx.x == 0) (void)xb_add(&bar[XB_XCNT(b.x)], 1u);
    return b;
}
__device__ __forceinline__ void xcd_barrier_complete(unsigned* bar, unsigned x, unsigned& nloc, unsigned& nx) {
    const unsigned G = gridDim.x * gridDim.y * gridDim.z;
    unsigned sum, cnt, mine, sp = 0u;
    for (;;) {
        sum = 0u; cnt = 0u; mine = 0u;
#pragma unroll
        for (unsigned j = 0; j < 16; ++j) { const unsigned c = xb_ld(&bar[XB_XCNT(j)]); sum += c; cnt += (c > 0u) ? 1u : 0u; mine = (j == x) ? c : mine; }
        if (sum == G) break;
        __builtin_amdgcn_s_sleep(1);
        if ((++sp & 255u) == 0u) { if (xb_ld(&bar[XB_TMO])) break; if (sp > XB_SPIN_CAP) { atomicAdd(&bar[XB_TMO], 1u); break; } }
    }
    nloc = mine > 0u ? mine : 1u; nx = cnt > 0u ? cnt : 1u;
}
__device__ __forceinline__ void xcd_barrier(const XcdBarrier& b) {
    asm volatile("s_waitcnt vmcnt(0)" ::: "memory");
    __syncthreads();
    if (threadIdx.x == 0) {
        unsigned* bar = b.bar;
        __builtin_amdgcn_s_waitcnt(0);
        unsigned nloc = b.st[0], nx = b.st[1];
        if (nloc == 0u) { xcd_barrier_complete(bar, b.x, nloc, nx); b.st[0] = nloc; b.st[1] = nx; }
        const unsigned old = xb_add(&bar[XB_XSUB(b.x)], 1u);
        const unsigned gen = old / nloc;
        if (old + 1u == (gen + 1u) * nloc) {
            __builtin_amdgcn_fence(__ATOMIC_RELEASE, "agent");
            asm volatile("s_waitcnt vmcnt(0)" ::: "memory");
            const unsigned og = xb_add(&bar[XB_TOP], 1u);
            const unsigned tg = og / nx;
            if (og + 1u == (tg + 1u) * nx) xb_add(&bar[XB_TOPGEN], 1u);
            else XB_SPIN(xb_ld(&bar[XB_TOPGEN]) == tg, bar);
            __builtin_amdgcn_fence(__ATOMIC_ACQUIRE, "agent");
            xb_add(&bar[XB_XGEN(b.x)], 1u);
            asm volatile("s_waitcnt vmcnt(0)" ::: "memory");
        } else {
            XB_SPIN(xb_ld(&bar[XB_XGEN(b.x)]) == gen, bar);
            __builtin_amdgcn_fence(__ATOMIC_ACQUIRE, "agent");
            asm volatile("s_waitcnt vmcnt(0)" ::: "memory");
        }
    }
    __syncthreads();
}

__device__ __forceinline__ pg8::Sched make_sched(int nN, int pairs, const void* A0, const void* A1, size_t atile, const void* B0, const void* B1, size_t btile) {
    pg8::Sched S; S.nM = NTOK / 256; S.nN = nN; S.nwg = S.nM * nN; S.G = gridDim.x; S.c = blockIdx.x; S.pairs = pairs;
    S.A0 = (const char*)A0; S.A1 = (const char*)A1; S.B0 = (const char*)B0; S.B1 = (const char*)B1; S.atile = atile; S.btile = btile; return S;
}

__global__ void __launch_bounds__(512, 2) fwd_kernel(const Params p) {
    extern __shared__ __attribute__((aligned(16))) unsigned char shm[];
    cg::grid_group grid = cg::this_grid();
    LAS unsigned char* lds = (LAS unsigned char*)shm;
    unsigned char* ws = p.ws;
    volatile LAS unsigned* xst = (volatile LAS unsigned*)(lds + XST_OFF);
    if (threadIdx.x == 0) { xst[0] = 0u; xst[1] = 0u; }
    __syncthreads();
    const XcdBarrier xb = xcd_barrier_post((unsigned*)(ws + OFF_BAR), xst);
    if (p.phase_hi > NPHASE) grid.sync();
#if USE_CG_SYNC
#define GSYNC() grid.sync()
#else
#define GSYNC() xcd_barrier(xb)
#endif
#ifndef PH_MASK
#define PH_MASK 0x7ff
#endif
#ifndef REPEAT_MASK
#define REPEAT_MASK 0
#endif
#define PHASE(n) if ((((PH_MASK) >> (n)) & 1) && p.phase_lo <= (n) && (n) < p.phase_hi) { if ((n) > p.phase_lo) GSYNC(); for (int rep_ = 0; rep_ <= (((REPEAT_MASK) >> (n)) & 1); ++rep_) { if (rep_) GSYNC();
#define PHASE_END } }
    PHASE(0) phase_prep(p, shm); PHASE_END
    PHASE(1) phase_h(p, shm); PHASE_END
    PHASE(2) { const pg8::Sched S = make_sched(44, 0, p.out, p.out, (size_t)256 * DM * 2, ws + OFF_WT_IN, ws + OFF_WT_IN, (size_t)256 * 2048 * 2);
               EpiG1 E; E.prec = (bf16_t*)(ws + OFF_PREC); E.pm_ = (bf16_t*)(ws + OFF_PM);
               pg8::gemm_phase(lds, 2048, DM, 2048, S, E); } PHASE_END
        PHASE(3) phase_rec2(p, shm); PHASE_END
    PHASE(5) { const pg8::Sched S = make_sched(8, 1, p.out, (const char*)p.out + 1024 * 2, (size_t)256 * DM * 2, ws + OFF_WT_UPA, ws + OFF_WT_UPB, (size_t)256 * 1024 * 2);
               EpiG2 E; E.merged = (bf16_t*)(ws + OFF_PREC); E.pm_ = (const bf16_t*)(ws + OFF_PM);
               pg8::gemm_phase(lds, 1024, DM, 1024, S, E); } PHASE_END
    PHASE(6) { const pg8::Sched S = make_sched(8, 0, ws + OFF_PREC, ws + OFF_PREC, (size_t)256 * DM * 2, ws + OFF_WT_O, ws + OFF_WT_O, (size_t)256 * 2048 * 2);
               EpiResT<false> E; E.xin = p.x; E.ldi = DM; E.xout = (bf16_t*)(ws + OFF_PM); E.ldo = MP; E.gt = (const float*)(ws + OFF_MOD) + 4096;
               pg8::gemm_phase(lds, 2048, DM, 2048, S, E); } PHASE_END
    PHASE(7) phase_h2(p); PHASE_END
    PHASE(8) { const pg8::Sched S = make_sched(44, 0, p.out, p.out, (size_t)256 * DM * 2, ws + OFF_WT_FFI, ws + OFF_WT_FFI, (size_t)256 * 2048 * 2);
               EpiG4 E; E.actb = (bf16_t*)(ws + OFF_PREC);
               pg8::gemm_phase(lds, 2048, DM, 2048, S, E); } PHASE_END
    PHASE(9) { const pg8::Sched S = make_sched(8, 0, ws + OFF_PREC, ws + OFF_PREC, (size_t)256 * FFH * 2, ws + OFF_WT_FFO, ws + OFF_WT_FFO, (size_t)256 * FFH * 2);
               EpiResT<true> E; E.xin = ws + OFF_PM; E.ldi = MP; E.xout = (bf16_t*)(ws + OFF_PM); E.ldo = MP; E.gt = (const float*)(ws + OFF_MOD) + 10240;
               pg8::gemm_phase(lds, FFH, FFH, FFH, S, E); } PHASE_END
    PHASE(10) phase_final(p); PHASE_END
#ifndef EXTRA_SYNCS
#define EXTRA_SYNCS 0
#endif
    for (int i = 0; i < EXTRA_SYNCS; ++i) GSYNC();
#undef PHASE
#undef PHASE_END
}

extern "C" void kernel_launch(void* const* d_in, const int* in_sizes, int n_in, void* d_out, int out_size, void* d_ws, size_t ws_size, hipStream_t stream) {
    static int grid = 0;
    if (grid == 0) {
        if (n_in != 18 || ws_size < WS_END) { fprintf(stderr, "kernel_launch: need 18 inputs and >= %zu bytes of workspace; got %d, %zu\n", (size_t)WS_END, n_in, ws_size); grid = -1; return; }
        int dev = 0, cus = 0, per_cu = 0;
        hipGetDevice(&dev);
        hipDeviceGetAttribute(&cus, hipDeviceAttributeMultiprocessorCount, dev);
        if (hipFuncSetAttribute((const void*)fwd_kernel, hipFuncAttributeMaxDynamicSharedMemorySize, LDS_BYTES) != hipSuccess) fprintf(stderr, "kernel_launch: hipFuncSetAttribute failed\n");
        if (hipOccupancyMaxActiveBlocksPerMultiprocessor(&per_cu, (const void*)fwd_kernel, 512, LDS_BYTES) != hipSuccess || per_cu < 1) { fprintf(stderr, "kernel_launch: occupancy query says %d\n", per_cu); per_cu = 1; }
        (void)hipGetLastError();
        grid = cus * 1;
    }
    if (grid < 0) return;
    (void)hipMemsetAsync((unsigned char*)d_ws + OFF_BAR, 0, BAR_BYTES, stream);
    Params p{};
    p.x = (const float*)d_in[0]; p.c = (const float*)d_in[1]; p.w_ada = (const float*)d_in[2]; p.b_ada = (const float*)d_in[3]; p.norm1_w = (const float*)d_in[4];
    p.w_in = (const float*)d_in[5]; p.w_gk2 = (const float*)d_in[6]; p.b_gk2 = (const float*)d_in[7]; p.lb_param = (const float*)d_in[8]; p.a_norm_w = (const float*)d_in[9];
    p.b_norm_w = (const float*)d_in[10]; p.w_up_a = (const float*)d_in[11]; p.w_up_b = (const float*)d_in[12]; p.w_o = (const float*)d_in[13]; p.norm2_w = (const float*)d_in[14];
    p.w_ffn_in = (const float*)d_in[15]; p.w_ffn_out = (const float*)d_in[16]; p.final_norm_w = (const float*)d_in[17];
    p.out = (float*)d_out; p.ws = (unsigned char*)d_ws;
#if ONE_LAUNCH
    p.phase_lo = 0; p.phase_hi = NPHASE;
    void* args[] = {(void*)&p};
    hipError_t e = hipLaunchCooperativeKernel((const void*)fwd_kernel, dim3(grid), dim3(512), args, LDS_BYTES, stream);
    if (e != hipSuccess) fprintf(stderr, "cooperative launch failed: %s (grid %d)\n", hipGetErrorString(e), grid);
#else
    for (int ph = 0; ph < NPHASE; ++ph) {
        p.phase_lo = ph; p.phase_hi = ph + 1;
        hipLaunchKernelGGL(fwd_kernel, dim3(grid), dim3(512), LDS_BYTES, stream, p);
    }
#endif
}
```

```cpp
#include <hip/hip_runtime.h>
#include <hip/hip_cooperative_groups.h>
#include <cstdio>
#include <cstdint>
namespace cg = cooperative_groups;

#ifndef ONE_LAUNCH
#define ONE_LAUNCH 1
#endif
#ifndef USE_CG_SYNC
#define USE_CG_SYNC 0
#endif
#ifndef NAIVE_GEMM
#define NAIVE_GEMM 0
#endif

#define LAS __attribute__((address_space(3)))
typedef unsigned short bf16_t;
typedef short bf16x8 __attribute__((ext_vector_type(8)));
typedef float f32x4 __attribute__((ext_vector_type(4)));
typedef unsigned u32x4 __attribute__((ext_vector_type(4)));
typedef unsigned u32x2 __attribute__((ext_vector_type(2)));

constexpr int NTOK = 16384, DM = 2048;
constexpr int PREC_W = 7168, PM_W = 4096 + 64, FFH = 5632, INW = 11280, NMOD = 12288;
constexpr float EPS = 1e-6f;
constexpr int XST_OFF = 163072;
constexpr int XP = 2048 + 32;
constexpr int MP = 2048 + 64;
constexpr int LDS_BYTES = XST_OFF + 64;
constexpr int NPHASE = 11;

constexpr size_t OFF_WT_IN  = 0;
constexpr size_t OFF_WT_UPA = OFF_WT_IN + (size_t)11264 * 2048 * 2;
constexpr size_t OFF_WT_UPB = OFF_WT_UPA + (size_t)2048 * 1024 * 2;
constexpr size_t OFF_WT_O   = OFF_WT_UPB + (size_t)2048 * 1024 * 2;
constexpr size_t OFF_WT_FFI = OFF_WT_O + (size_t)2048 * 2048 * 2;
constexpr size_t OFF_WT_FFO = OFF_WT_FFI + (size_t)11264 * 2048 * 2;
constexpr size_t OFF_MOD    = OFF_WT_FFO + (size_t)2048 * 5632 * 2;
constexpr size_t OFF_GKL    = OFF_MOD + (size_t)8 * 12288 * 4;
constexpr size_t OFF_PREC   = OFF_GKL + (size_t)16384 * 16 * 4;
constexpr size_t OFF_PM     = OFF_PREC + (size_t)16384 * 7168 * 2;
constexpr size_t OFF_BAR    = OFF_PM + (size_t)16384 * PM_W * 2;
constexpr size_t BAR_BYTES  = 16384;
constexpr size_t OFF_GDEC   = OFF_BAR + BAR_BYTES;
constexpr size_t OFF_GRAN   = OFF_GDEC + (size_t)16384 * 512 * 2;
constexpr size_t GRAN_BYTES = (size_t)256 * 32 * 64 * 8;
constexpr size_t WS_END     = OFF_GRAN + GRAN_BYTES;

struct Params {
    const float *x, *c, *w_ada, *b_ada, *norm1_w, *w_in, *w_gk2, *b_gk2, *lb_param, *a_norm_w, *b_norm_w, *w_up_a, *w_up_b, *w_o, *norm2_w, *w_ffn_in, *w_ffn_out, *final_norm_w;
    float* out; unsigned char* ws;
    int phase_lo, phase_hi;
};

__device__ __forceinline__ unsigned pk2(float lo, float hi) { unsigned r; asm("v_cvt_pk_bf16_f32 %0, %1, %2" : "=v"(r) : "v"(lo), "v"(hi)); return r; }
__device__ __forceinline__ float bflo(unsigned u) { return __uint_as_float(u << 16); }
__device__ __forceinline__ float bfhi(unsigned u) { return __uint_as_float(u & 0xffff0000u); }
__device__ __forceinline__ float bf1(bf16_t b) { return __uint_as_float(((unsigned)b) << 16); }
__device__ __forceinline__ float sigmoidf_(float v) { return __builtin_amdgcn_rcpf(1.f + __expf(-v)); }
__device__ __forceinline__ float siluf_(float v) { return v * sigmoidf_(v); }
__device__ __forceinline__ int opaque_tid() { int t = threadIdx.x; asm volatile("" : "+v"(t)); return t; }
__device__ __forceinline__ float wave_sum(float v) {
#pragma unroll
    for (int o = 1; o < 64; o <<= 1) v += __shfl_xor(v, o);
    return v;
}

namespace pg8 {
constexpr int BM = 256, BK = 64, HALF = 128, HTB = HALF * BK * 2, STAGE_BYTES = 8 * HTB, NXCD = 8, WGM = 8;
__host__ __device__ __forceinline__ int lds_byte(int r, int c) { const int st = (r >> 4) * 2 + (c >> 5), rr = r & 15, cc = c & 31, ob = rr * 64 + cc * 2; return st * 1024 + (ob ^ (((ob >> 9) & 1) << 5)); }
__host__ __device__ __forceinline__ void stage_rc(int b, int& R, int& C) { const int st = b / 1024, sb = b % 1024, swz = sb ^ (((sb >> 9) & 1) << 5); R = (st >> 1) * 16 + swz / 64; C = (st & 1) * 32 + (swz % 64) / 2; }
__host__ __device__ __forceinline__ int perm32(int rho) { const int n = rho >> 4, i = rho & 15; return 8 * (i >> 2) + 4 * n + (i & 3); }

struct Unit { int pm, pn, aux; const char* A; const char* B; };

struct Sched {
    int nM, nN, nwg, G, c, pairs;
    const char *A0, *A1, *B0, *B1; size_t atile, btile;
    __device__ __forceinline__ bool next(int i, Unit& u) const {
        const int ti = pairs ? (i >> 1) : i, s = pairs ? (i & 1) : 0;
        const long L = (long)ti * G + c; if (L >= nwg) return false;
        int wgid = (int)L; { const int q = nwg / NXCD, r = nwg % NXCD, xcd = wgid % NXCD, off = wgid / NXCD; wgid = (xcd < r ? xcd * (q + 1) : r * (q + 1) + (xcd - r) * q) + off; }
        const int nig = WGM * nN, gid = wgid / nig, fm = gid * WGM, gsz = (nM - fm) < WGM ? (nM - fm) : WGM;
        u.pm = fm + ((wgid % nig) % gsz); u.pn = (wgid % nig) / gsz; u.aux = s;
        u.A = (s ? A1 : A0) + (size_t)u.pm * atile; u.B = (s ? B1 : B0) + (size_t)u.pn * btile; return true;
    }
};

#ifndef GEMM_SP2
#define GEMM_SP2 1
#endif
#ifndef GEMM_ALIGN
#define GEMM_ALIGN 1
#endif
#if !NAIVE_GEMM
template <class Epi, bool ALIGN_EPI = (GEMM_ALIGN != 0), bool SP2 = (GEMM_SP2 != 0)>
__device__ __forceinline__ void gemm_phase(LAS unsigned char* lds, const int K, const int lda, const int ldb, const Sched& S, const Epi& E) {
    int tid_ = threadIdx.x; asm volatile("" : "+v"(tid_));
    const int tid = tid_, wid = __builtin_amdgcn_readfirstlane(tid >> 6), lane = tid & 63, wr = wid >> 2, wc = wid & 3, fr = lane & 15, fq = lane >> 4;
    const int nt = K / BK;
    unsigned voffA[2], voffB[2];
#pragma unroll
    for (int i = 0; i < 2; ++i) { int R, C; stage_rc(tid * 16 + i * 8192, R, C); const int Rb = (R & ~31) + perm32(R & 31);
        voffA[i] = (unsigned)(R * lda + C) * 2u; voffB[i] = (unsigned)(Rb * ldb + C) * 2u; }
    const size_t kstep = (size_t)(BK * 2);
    const size_t hstepA = (size_t)HALF * lda * 2, hstepB = (size_t)HALF * ldb * 2;
    const unsigned ldsw = (unsigned)wid * 1024u;
    const int aoff = lds_byte(wr * 64 + fr, fq * 8), boff = lds_byte(wc * 32 + fr, fq * 8);
#define PG8_SA(b, h) (((b) * 2 + (h)) * HTB)
#define PG8_SB(b, h) ((4 + (b) * 2 + (h)) * HTB)
#define PG8_STAGE(bufoff, gbase, voff) do { _Pragma("unroll") for (int _i = 0; _i < 2; ++_i) \
        __builtin_amdgcn_global_load_lds((const unsigned*)((const char*)(gbase) + (voff)[_i]), (LAS unsigned*)(lds + (bufoff) + ldsw + _i * 8192), 16, 0, 0); } while (0)
#define PG8_LDA(dst, b, h) do { _Pragma("unroll") for (int m = 0; m < 4; ++m) _Pragma("unroll") for (int k = 0; k < 2; ++k) dst[m][k] = *(const LAS bf16x8*)(lds + PG8_SA(b, h) + aoff + m * 2048 + k * 1024); } while (0)
#define PG8_LDB(dst, b, h) do { _Pragma("unroll") for (int n = 0; n < 2; ++n) _Pragma("unroll") for (int k = 0; k < 2; ++k) dst[n][k] = *(const LAS bf16x8*)(lds + PG8_SB(b, h) + boff + n * 2048 + k * 1024); } while (0)
#define PG8_MMA(ai, bj, At, Bt) do { __builtin_amdgcn_s_setprio(1); _Pragma("unroll") for (int m = 0; m < 4; ++m) _Pragma("unroll") for (int n = 0; n < 2; ++n) _Pragma("unroll") for (int k = 0; k < 2; ++k) \
        acc[ai][bj][m][n] = __builtin_amdgcn_mfma_f32_16x16x32_bf16(Bt[n][k], At[m][k], acc[ai][bj][m][n], 0, 0, 0); __builtin_amdgcn_s_setprio(0); } while (0)
#define PG8_WAIT_V(n) asm volatile("s_waitcnt vmcnt(" #n ")" ::: "memory")
#define PG8_WAIT_L(n) asm volatile("s_waitcnt lgkmcnt(" #n ")" ::: "memory")
#define PG8_BAR __builtin_amdgcn_s_barrier()
#define PG8_SCHED __builtin_amdgcn_sched_barrier(0)
    Unit cur, nxt; int ui = 0;
    if (!S.next(0, cur)) return;
    f32x4 acc[2][2][4][2];
#pragma unroll
    for (int a = 0; a < 2; ++a)
#pragma unroll
        for (int b = 0; b < 2; ++b)
#pragma unroll
            for (int m = 0; m < 4; ++m)
#pragma unroll
                for (int n = 0; n < 2; ++n) acc[a][b][m][n] = (f32x4){0.f, 0.f, 0.f, 0.f};
    bf16x8 At[4][2], B0[2][2], B1[2][2];
    const char* cA = cur.A; const char* cB = cur.B;
    if constexpr (SP2) {
        PG8_STAGE(PG8_SB(0, 0), cB, voffB); PG8_STAGE(PG8_SB(0, 1), cB + hstepB, voffB); PG8_STAGE(PG8_SA(0, 0), cA, voffA); PG8_STAGE(PG8_SA(0, 1), cA + hstepA, voffA);
        if (wr == 1) PG8_BAR;
        PG8_WAIT_V(2); PG8_BAR;
        PG8_STAGE(PG8_SB(1, 0), cB + kstep, voffB); PG8_STAGE(PG8_SA(1, 0), cA + kstep, voffA); PG8_STAGE(PG8_SB(1, 1), cB + hstepB + kstep, voffB);
        PG8_WAIT_V(6); PG8_BAR;
    } else {
        PG8_STAGE(PG8_SB(0, 0), cB, voffB); PG8_STAGE(PG8_SA(0, 0), cA, voffA); PG8_STAGE(PG8_SB(0, 1), cB + hstepB, voffB); PG8_STAGE(PG8_SA(0, 1), cA + hstepA, voffA);
        if (wr == 1) PG8_BAR;
        PG8_WAIT_V(4); PG8_BAR;
        PG8_STAGE(PG8_SB(1, 0), cB + kstep, voffB); PG8_STAGE(PG8_SA(1, 0), cA + kstep, voffA); PG8_STAGE(PG8_SB(1, 1), cB + hstepB + kstep, voffB);
        PG8_WAIT_V(6); PG8_BAR;
    }
    for (;;) {
        const bool has_next = S.next(ui + 1, nxt);
        const char* nA = has_next ? nxt.A : cA; const char* nB = has_next ? nxt.B : cB;
        for (int t = 0; t < nt; t += 2) {
            const bool last = (t == nt - 2);
            const char* a1 = cA + (size_t)(t + 1) * kstep;
            const char* a2 = last ? nA : cA + (size_t)(t + 2) * kstep; const char* b2 = last ? nB : cB + (size_t)(t + 2) * kstep;
            const char* a3 = a2 + kstep; const char* b3 = b2 + kstep;
            if constexpr (SP2) {
            PG8_LDB(B0, 0, 0); PG8_LDB(B1, 0, 1); PG8_SCHED; PG8_LDA(At, 0, 0); PG8_STAGE(PG8_SA(1, 1), a1 + hstepA, voffA);
            PG8_WAIT_V(8); PG8_WAIT_L(0); PG8_BAR; PG8_MMA(0, 0, At, B0); PG8_MMA(0, 1, At, B1); PG8_BAR; PG8_SCHED;
            PG8_LDA(At, 0, 1); PG8_STAGE(PG8_SB(0, 0), b2, voffB); PG8_STAGE(PG8_SB(0, 1), b2 + hstepB, voffB); PG8_STAGE(PG8_SA(0, 0), a2, voffA);
            PG8_WAIT_V(8); PG8_WAIT_L(0); PG8_BAR; PG8_MMA(1, 0, At, B0); PG8_MMA(1, 1, At, B1); PG8_BAR; PG8_SCHED;
            PG8_LDB(B0, 1, 0); PG8_LDB(B1, 1, 1); PG8_SCHED; PG8_LDA(At, 1, 0); PG8_STAGE(PG8_SA(0, 1), a2 + hstepA, voffA);
            PG8_WAIT_V(8); PG8_WAIT_L(0); PG8_BAR; PG8_MMA(0, 0, At, B0); PG8_MMA(0, 1, At, B1); PG8_BAR; PG8_SCHED;
            PG8_LDA(At, 1, 1); PG8_STAGE(PG8_SB(1, 0), b3, voffB); PG8_STAGE(PG8_SB(1, 1), b3 + hstepB, voffB); PG8_STAGE(PG8_SA(1, 0), a3, voffA);
            PG8_WAIT_V(8); PG8_WAIT_L(0); PG8_BAR; PG8_MMA(1, 0, At, B0); PG8_MMA(1, 1, At, B1); PG8_BAR; PG8_SCHED;
            } else {
            PG8_LDB(B0, 0, 0); PG8_SCHED; PG8_LDA(At, 0, 0); PG8_STAGE(PG8_SA(1, 1), a1 + hstepA, voffA);
            PG8_WAIT_L(8); PG8_BAR; PG8_WAIT_L(0); PG8_MMA(0, 0, At, B0); PG8_BAR; PG8_SCHED;
            PG8_LDB(B1, 0, 1); PG8_STAGE(PG8_SB(0, 0), b2, voffB);
            PG8_BAR; PG8_WAIT_L(0); PG8_MMA(0, 1, At, B1); PG8_BAR;
            PG8_LDA(At, 0, 1); PG8_STAGE(PG8_SA(0, 0), a2, voffA);
            PG8_BAR; PG8_WAIT_L(0); PG8_MMA(1, 0, At, B0); PG8_BAR; PG8_SCHED;
            PG8_STAGE(PG8_SB(0, 1), b2 + hstepB, voffB);
            PG8_WAIT_V(6); PG8_BAR; PG8_MMA(1, 1, At, B1); PG8_BAR;
            PG8_LDB(B0, 1, 0); PG8_SCHED; PG8_LDA(At, 1, 0); PG8_STAGE(PG8_SA(0, 1), a2 + hstepA, voffA);
            PG8_WAIT_L(8); PG8_BAR; PG8_WAIT_L(0); PG8_MMA(0, 0, At, B0); PG8_BAR; PG8_SCHED;
            PG8_LDB(B1, 1, 1); PG8_STAGE(PG8_SB(1, 0), b3, voffB);
            PG8_BAR; PG8_WAIT_L(0); PG8_MMA(0, 1, At, B1); PG8_BAR;
            PG8_LDA(At, 1, 1); PG8_STAGE(PG8_SA(1, 0), a3, voffA);
            PG8_BAR; PG8_WAIT_L(0); PG8_MMA(1, 0, At, B0); PG8_BAR; PG8_SCHED;
            PG8_STAGE(PG8_SB(1, 1), b3 + hstepB, voffB);
            PG8_WAIT_V(6); PG8_BAR; PG8_MMA(1, 1, At, B1); PG8_BAR;
            }
        }
        if constexpr (ALIGN_EPI) { if (wr == 0) PG8_BAR; }
        E(acc, cur, wr, wc, fr, fq);
        if (!has_next) break;
        if (!(Epi::KEEP_ACC && cur.aux == 0)) {
#pragma unroll
        for (int a = 0; a < 2; ++a)
#pragma unroll
            for (int b = 0; b < 2; ++b)
#pragma unroll
                for (int m = 0; m < 4; ++m)
#pragma unroll
                    for (int n = 0; n < 2; ++n) acc[a][b][m][n] = (f32x4){0.f, 0.f, 0.f, 0.f};
        }
        cur = nxt; cA = nA; cB = nB; ++ui;
        if constexpr (ALIGN_EPI) { if (wr == 1) PG8_BAR; }
    }
    PG8_WAIT_V(0);
    if constexpr (!ALIGN_EPI) { if (wr == 0) PG8_BAR; }
    PG8_BAR;
#undef PG8_SA
#undef PG8_SB
#undef PG8_STAGE
#undef PG8_LDA
#undef PG8_LDB
#undef PG8_MMA
#undef PG8_WAIT_V
#undef PG8_WAIT_L
#undef PG8_BAR
#undef PG8_SCHED
}
#else
template <class Epi, bool ALIGN_EPI = false, bool SP2 = false>
__device__ __forceinline__ void gemm_phase(LAS unsigned char* lds, const int K, const int lda, const int ldb, const Sched& S, const Epi& E) {
    const int tid = opaque_tid(), wid = tid >> 6, lane = tid & 63, wr = wid >> 2, wc = wid & 3, fr = lane & 15, fq = lane >> 4;
    Unit cur;
    f32x4 acc[2][2][4][2];
    for (int ui = 0; S.next(ui, cur); ++ui) {
        if (!(Epi::KEEP_ACC && cur.aux == 1))
#pragma unroll
        for (int a = 0; a < 2; ++a)
#pragma unroll
            for (int b = 0; b < 2; ++b)
#pragma unroll
                for (int m = 0; m < 4; ++m)
#pragma unroll
                    for (int n = 0; n < 2; ++n) acc[a][b][m][n] = (f32x4){0.f, 0.f, 0.f, 0.f};
        for (int kb = 0; kb < K; kb += 32) {
#pragma unroll
            for (int ai = 0; ai < 2; ++ai)
#pragma unroll
                for (int bj = 0; bj < 2; ++bj) {
                    bf16x8 bf[2];
#pragma unroll
                    for (int n = 0; n < 2; ++n) bf[n] = *(const bf16x8*)(cur.B + ((size_t)(bj * 128 + wc * 32 + perm32(16 * n + fr)) * ldb + kb + fq * 8) * 2);
#pragma unroll
                    for (int m = 0; m < 4; ++m) {
                        const bf16x8 af = *(const bf16x8*)(cur.A + ((size_t)(ai * 128 + wr * 64 + m * 16 + fr) * lda + kb + fq * 8) * 2);
#pragma unroll
                        for (int n = 0; n < 2; ++n) acc[ai][bj][m][n] = __builtin_amdgcn_mfma_f32_16x16x32_bf16(bf[n], af, acc[ai][bj][m][n], 0, 0, 0);
                    }
                }
        }
        E(acc, cur, wr, wc, fr, fq);
    }
}
#endif
}
using pg8::Unit;

struct EpiG1 {
    static constexpr bool KEEP_ACC = false;
    bf16_t* prec; bf16_t* pm_;
    __device__ __forceinline__ void operator()(const f32x4 (&acc)[2][2][4][2], const Unit& u, int wr, int wc, int fr, int fq) const {
        const int pn = u.pn;
        const int act = pn < 4 ? 1 : (pn >= 28 ? 2 : ((pn == 16 || pn == 17) ? 3 : 0));
        bf16_t* base; int ld, c0;
        if (pn < 28) { base = prec; ld = PREC_W; c0 = pn * 256; } else { base = pm_; ld = PM_W; c0 = (pn - 28) * 256; }
#pragma unroll
        for (int ai = 0; ai < 2; ++ai)
#pragma unroll
            for (int m = 0; m < 4; ++m) {
                const int row = u.pm * 256 + ai * 128 + wr * 64 + m * 16 + fr;
                bf16_t* rp = base + (size_t)row * ld + c0 + wc * 32 + 8 * fq;
#pragma unroll
                for (int bj = 0; bj < 2; ++bj) {
                    f32x4 v0 = acc[ai][bj][m][0], v1 = acc[ai][bj][m][1];
                    if (act == 1) {
#pragma unroll
                        for (int j = 0; j < 4; ++j) { v0[j] = siluf_(v0[j]); v1[j] = siluf_(v1[j]); }
                    } else if (act == 2) {
#pragma unroll
                        for (int j = 0; j < 4; ++j) { v0[j] = sigmoidf_(v0[j]); v1[j] = sigmoidf_(v1[j]); }
                    } else if (act == 3) { v0 = v0 * 0.08838834764831845f; v1 = v1 * 0.08838834764831845f; }
                    __builtin_nontemporal_store((u32x4){pk2(v0[0], v0[1]), pk2(v0[2], v0[3]), pk2(v1[0], v1[1]), pk2(v1[2], v1[3])}, (u32x4*)(rp + bj * 128));
                }
            }
    }
};
struct EpiG2 {
    static constexpr bool KEEP_ACC = true;
    bf16_t* merged; const bf16_t* pm_;
    __device__ __forceinline__ void operator()(f32x4 (&acc)[2][2][4][2], const Unit& u, int wr, int wc, int fr, int fq) const {
        const int s = u.aux;
#pragma unroll
        for (int ai = 0; ai < 2; ++ai)
#pragma unroll
            for (int m = 0; m < 4; ++m) {
                const int row = u.pm * 256 + ai * 128 + wr * 64 + m * 16 + fr;
#pragma unroll
                for (int bj = 0; bj < 2; ++bj) {
                    const int c = u.pn * 256 + bj * 128 + wc * 32 + 8 * fq;
                    const u32x4 gb = *(const u32x4*)(pm_ + (size_t)row * PM_W + 2048 + c);
                    if (s == 0) {
                        const u32x4 ga = *(const u32x4*)(pm_ + (size_t)row * PM_W + c);
#pragma unroll
                        for (int q = 0; q < 2; ++q) {
                            acc[ai][bj][m][0][2 * q] *= bflo(ga[q]) * __builtin_amdgcn_rcpf(bflo(gb[q])); acc[ai][bj][m][0][2 * q + 1] *= bfhi(ga[q]) * __builtin_amdgcn_rcpf(bfhi(gb[q]));
                            acc[ai][bj][m][1][2 * q] *= bflo(ga[2 + q]) * __builtin_amdgcn_rcpf(bflo(gb[2 + q])); acc[ai][bj][m][1][2 * q + 1] *= bfhi(ga[2 + q]) * __builtin_amdgcn_rcpf(bfhi(gb[2 + q]));
                        }
                    } else {
                        const f32x4 a0 = acc[ai][bj][m][0], a1 = acc[ai][bj][m][1];
                        float v[8];
                        v[0] = a0[0] * bflo(gb[0]); v[1] = a0[1] * bfhi(gb[0]); v[2] = a0[2] * bflo(gb[1]); v[3] = a0[3] * bfhi(gb[1]);
                        v[4] = a1[0] * bflo(gb[2]); v[5] = a1[1] * bfhi(gb[2]); v[6] = a1[2] * bflo(gb[3]); v[7] = a1[3] * bfhi(gb[3]);
                        *(u32x4*)(merged + (size_t)row * DM + c) = (u32x4){pk2(v[0], v[1]), pk2(v[2], v[3]), pk2(v[4], v[5]), pk2(v[6], v[7])};
                    }
                }
            }
    }
};
template <bool IN_BF16> struct EpiResT {
    static constexpr bool KEEP_ACC = false;
    const void* xin; bf16_t* xout; const float* gt; int ldi, ldo;
    __device__ __forceinline__ void operator()(const f32x4 (&acc)[2][2][4][2], const Unit& u, int wr, int wc, int fr, int fq) const {
        const int b = (u.pm * 256) >> 11;
#pragma unroll
        for (int bj = 0; bj < 2; ++bj) {
            const int c = u.pn * 256 + bj * 128 + wc * 32 + 8 * fq;
            const f32x4 g0 = *(const f32x4*)(gt + (size_t)b * NMOD + c), g1 = *(const f32x4*)(gt + (size_t)b * NMOD + c + 4);
#pragma unroll
            for (int ai = 0; ai < 2; ++ai)
#pragma unroll
                for (int m = 0; m < 4; ++m) {
                    const int row = u.pm * 256 + ai * 128 + wr * 64 + m * 16 + fr;
                    f32x4 x0, x1;
                    if (IN_BF16) { const u32x4 xv = *(const u32x4*)((const bf16_t*)xin + (size_t)row * ldi + c);
                        x0 = (f32x4){bflo(xv[0]), bfhi(xv[0]), bflo(xv[1]), bfhi(xv[1])}; x1 = (f32x4){bflo(xv[2]), bfhi(xv[2]), bflo(xv[3]), bfhi(xv[3])}; }
                    else { const float* ip = (const float*)xin + (size_t)row * ldi + c; x0 = *(const f32x4*)ip; x1 = *(const f32x4*)(ip + 4); }
                    const f32x4 r0 = x0 + g0 * acc[ai][bj][m][0], r1 = x1 + g1 * acc[ai][bj][m][1];
                    *(u32x4*)(xout + (size_t)row * ldo + c) = (u32x4){pk2(r0[0], r0[1]), pk2(r0[2], r0[3]), pk2(r1[0], r1[1]), pk2(r1[2], r1[3])};
                }
        }
    }
};
struct EpiG4 {
    static constexpr bool KEEP_ACC = false;
    bf16_t* actb;
    __device__ __forceinline__ void operator()(const f32x4 (&acc)[2][2][4][2], const Unit& u, int wr, int wc, int fr, int fq) const {
#pragma unroll
        for (int ai = 0; ai < 2; ++ai)
#pragma unroll
            for (int m = 0; m < 4; ++m) {
                const int row = u.pm * 256 + ai * 128 + wr * 64 + m * 16 + fr;
                const f32x4 g0 = acc[ai][0][m][0], g1 = acc[ai][0][m][1], u0 = acc[ai][1][m][0], u1 = acc[ai][1][m][1];
                float v[8];
#pragma unroll
                for (int j = 0; j < 4; ++j) { v[j] = siluf_(g0[j]) * u0[j]; v[4 + j] = siluf_(g1[j]) * u1[j]; }
                *(u32x4*)(actb + (size_t)row * FFH + u.pn * 128 + wc * 32 + 8 * fq) = (u32x4){pk2(v[0], v[1]), pk2(v[2], v[3]), pk2(v[4], v[5]), pk2(v[6], v[7])};
            }
    }
};

__device__ __forceinline__ void tr_tile(const float* __restrict__ src, const int ldsrc, const int c_lo, const int c_hi, const int k0, bf16_t* __restrict__ dst, const int K, const int n0, unsigned char* lds) {
    bf16_t* T = (bf16_t*)lds;
    const int tid = opaque_tid();
    f32x4 v[8];
#pragma unroll
    for (int i = 0; i < 8; ++i) {
        const int idx = tid + 512 * i, r = idx >> 6, c4 = idx & 63;
        v[i] = *(const f32x4*)(src + (size_t)(k0 + r) * ldsrc + (c4 < 32 ? c_lo + 4 * c4 : c_hi + 4 * (c4 - 32)));
    }
#pragma unroll
    for (int i = 0; i < 8; ++i) {
        const int idx = tid + 512 * i, r = idx >> 6, c4 = idx & 63;
        const unsigned p01 = pk2(v[i][0], v[i][1]), p23 = pk2(v[i][2], v[i][3]);
        T[(4 * c4 + 0) * 72 + r] = (bf16_t)(p01 & 0xffffu); T[(4 * c4 + 1) * 72 + r] = (bf16_t)(p01 >> 16);
        T[(4 * c4 + 2) * 72 + r] = (bf16_t)(p23 & 0xffffu); T[(4 * c4 + 3) * 72 + r] = (bf16_t)(p23 >> 16);
    }
    __syncthreads();
#pragma unroll
    for (int i = 0; i < 4; ++i) {
        const int idx = tid + 512 * i, n = idx >> 3, k8 = idx & 7;
        __builtin_nontemporal_store(*(const u32x4*)(T + n * 72 + 8 * k8), (u32x4*)(dst + (size_t)(n0 + n) * K + k0 + 8 * k8));
    }
    __syncthreads();
}

struct TrTile { const float* sp; size_t ldsrc; bf16_t* dst; int K; };
__device__ __forceinline__ TrTile tr_make(const float* src, int ldsrc, int c_lo, int c_hi, int k0, bf16_t* dst, int K, int n0, int tid) {
    const int n = tid & 255, kh = tid >> 8;
    TrTile t; t.sp = src + (size_t)(k0 + 32 * kh) * ldsrc + (n < 128 ? c_lo + n : c_hi + n - 128); t.ldsrc = (size_t)ldsrc; t.dst = dst + (size_t)n0 * K + k0; t.K = K; return t;
}
constexpr int LT_UP = 16 * 8, LT_O = 32 * 8, LT_FFI = 32 * 44, LT_FFO = 88 * 8, LT_TOTAL = 2 * LT_UP + LT_O + LT_FFI + LT_FFO;
__device__ __forceinline__ TrTile later_tile(const Params& p, int r, int tid) {
    if (r < LT_UP) { const int kt = r / 8, nt = r % 8; return tr_make(p.w_up_a, 2048, nt * 256, nt * 256 + 128, kt * 64, (bf16_t*)(p.ws + OFF_WT_UPA), 1024, nt * 256, tid); } r -= LT_UP;
    if (r < LT_UP) { const int kt = r / 8, nt = r % 8; return tr_make(p.w_up_b, 2048, nt * 256, nt * 256 + 128, kt * 64, (bf16_t*)(p.ws + OFF_WT_UPB), 1024, nt * 256, tid); } r -= LT_UP;
    if (r < LT_O) { const int kt = r / 8, nt = r % 8; return tr_make(p.w_o, 2048, nt * 256, nt * 256 + 128, kt * 64, (bf16_t*)(p.ws + OFF_WT_O), 2048, nt * 256, tid); } r -= LT_O;
    if (r < LT_FFI) { const int kt = r / 44, nt = r % 44; return tr_make(p.w_ffn_in, 2 * FFH, 128 * nt, FFH + 128 * nt, kt * 64, (bf16_t*)(p.ws + OFF_WT_FFI), 2048, nt * 256, tid); } r -= LT_FFI;
    { const int kt = r / 8, nt = r % 8; return tr_make(p.w_ffn_out, 2048, nt * 256, nt * 256 + 128, kt * 64, (bf16_t*)(p.ws + OFF_WT_FFO), FFH, nt * 256, tid); }
}
__device__ __forceinline__ void tr_load(const TrTile& t, float (&v)[32]) {
#pragma unroll
    for (int i = 0; i < 32; ++i) v[i] = t.sp[(size_t)i * t.ldsrc];
}
__device__ __forceinline__ void tr_to_lds(bf16_t* T, const float (&v)[32], int tid) {
    const int n = tid & 255, kh = tid >> 8;
#pragma unroll
    for (int q = 0; q < 8; ++q) *(u32x2*)(T + n * 68 + 32 * kh + 4 * q) = (u32x2){pk2(v[4 * q], v[4 * q + 1]), pk2(v[4 * q + 2], v[4 * q + 3])};
}
__device__ __forceinline__ void tr_store(const bf16_t* T, const TrTile& t, int tid) {
#pragma unroll
    for (int i = 0; i < 4; ++i) {
        const int idx = tid + 512 * i, nn = idx >> 3, k8 = idx & 7;
        const u32x2 lo = *(const u32x2*)(T + nn * 68 + 8 * k8), hi = *(const u32x2*)(T + nn * 68 + 8 * k8 + 4);
        __builtin_nontemporal_store((u32x4){lo[0], lo[1], hi[0], hi[1]}, (u32x4*)(t.dst + (size_t)nn * t.K + 8 * k8));
    }
}
__device__ __forceinline__ void mod_job(const Params& p, const int job, unsigned char* lds) {
    float* sc = (float*)lds;
    float* red = (float*)(lds + 65536);
    const int tid = opaque_tid(), lane = tid & 63, wave = tid >> 6;
    for (int i = tid; i < 8 * 2048; i += 512) sc[i] = siluf_(p.c[i]);
    __syncthreads();
    const int cg4 = lane & 15, ks = wave * 4 + (lane >> 4);
    const int col = job * 64 + cg4 * 4;
    f32x4 acc[8];
#pragma unroll
    for (int b = 0; b < 8; ++b) acc[b] = (f32x4){0.f, 0.f, 0.f, 0.f};
    const float* wp = p.w_ada + (size_t)(ks * 64) * NMOD + col;
#pragma unroll 8
    for (int kk = 0; kk < 64; ++kk) {
        const f32x4 w = *(const f32x4*)(wp + (size_t)kk * NMOD);
        const int k = ks * 64 + kk;
#pragma unroll
        for (int b = 0; b < 8; ++b) acc[b] += w * sc[b * 2048 + k];
    }
#pragma unroll
    for (int b = 0; b < 8; ++b)
#pragma unroll
        for (int j = 0; j < 4; ++j) { float v = acc[b][j]; v += __shfl_xor(v, 16); v += __shfl_xor(v, 32); if (lane < 16) red[(wave * 8 + b) * 64 + cg4 * 4 + j] = v; }
    __syncthreads();
    { const int b = tid >> 6, cc = tid & 63; float s = 0.f;
#pragma unroll
      for (int w = 0; w < 8; ++w) s += red[(w * 8 + b) * 64 + cc];
      ((float*)(p.ws + OFF_MOD))[b * NMOD + job * 64 + cc] = s + p.b_ada[job * 64 + cc]; }
    __syncthreads();
}
__device__ __forceinline__ void phase_prep(const Params& p, unsigned char* lds) {
    constexpr int NMODJ = 192, T_IN = 32 * 44, NJOBS = NMODJ + T_IN;
    {   u32x4* g = (u32x4*)(p.ws + OFF_GRAN);
        for (size_t i = (size_t)blockIdx.x * 512 + threadIdx.x; i < GRAN_BYTES / 16; i += (size_t)gridDim.x * 512) g[i] = (u32x4){0u, 0u, 0u, 0u}; }
    for (int j = blockIdx.x; j < NJOBS; j += gridDim.x) {
        int r = j;
        if (r < NMODJ) { mod_job(p, r, lds); continue; } r -= NMODJ;
        { const int kt = r / 44, nt = r % 44, n0 = nt * 256, c0 = n0 < 7168 ? n0 : n0 + 16; tr_tile(p.w_in, INW, c0, c0 + 128, kt * 64, (bf16_t*)(p.ws + OFF_WT_IN), 2048, n0, lds); }
    }
}

__device__ __forceinline__ void phase_h(const Params& p, unsigned char* lds) {
    bf16_t* wg = (bf16_t*)lds;
    const int tid = opaque_tid(), lane = tid & 63, wave = tid >> 6;
    for (int i = tid; i < 8192; i += 512) { const int k = i >> 2, q = i & 3; const f32x4 v = *(const f32x4*)(p.w_in + (size_t)k * INW + 7168 + 4 * q);
        *(u32x2*)(wg + k * 16 + 4 * q) = (u32x2){pk2(v[0], v[1]), pk2(v[2], v[3])}; }
    float* wk2 = (float*)(lds + 65536);
    for (int i = tid; i < 2048; i += 512) *(f32x4*)(wk2 + 4 * i) = *(const f32x4*)(p.w_gk2 + 4 * i);
    __syncthreads();
    const f32x4 bk0 = *(const f32x4*)(p.b_gk2 + 8 * lane), bk1 = *(const f32x4*)(p.b_gk2 + 8 * lane + 4);
    const float* MOD = (const float*)(p.ws + OFF_MOD); bf16_t* H = (bf16_t*)p.out; bf16_t* GDEC = (bf16_t*)(p.ws + OFF_GDEC);
    const int rstep = gridDim.x * 8;
    for (int row = blockIdx.x * 8 + wave; row < NTOK; row += rstep) {
        const int b = row >> 11;
        f32x4 xv[8];
#pragma unroll
        for (int i = 0; i < 8; ++i) xv[i] = *(const f32x4*)(p.x + (size_t)row * DM + i * 256 + lane * 4);
        const int rnext = row + rstep < NTOK ? row + rstep : row;
        const float pf = p.x[(size_t)rnext * DM + lane * 32];
        float ss = 0.f;
#pragma unroll
        for (int i = 0; i < 8; ++i) ss += xv[i][0] * xv[i][0] + xv[i][1] * xv[i][1] + xv[i][2] * xv[i][2] + xv[i][3] * xv[i][3];
        ss = wave_sum(ss);
        const float rstd = rsqrtf(ss * (1.f / 2048.f) + EPS);
        float part[16];
#pragma unroll
        for (int n = 0; n < 16; ++n) part[n] = 0.f;
#pragma unroll
        for (int i = 0; i < 8; ++i) {
            const int col = i * 256 + lane * 4;
            const f32x4 w = *(const f32x4*)(p.norm1_w + col), sc = *(const f32x4*)(MOD + (size_t)b * NMOD + 2048 + col), sh = *(const f32x4*)(MOD + (size_t)b * NMOD + col);
            f32x4 hv;
#pragma unroll
            for (int j = 0; j < 4; ++j) hv[j] = xv[i][j] * rstd * w[j] * (1.f + sc[j]) + sh[j];
            __builtin_nontemporal_store((u32x2){pk2(hv[0], hv[1]), pk2(hv[2], hv[3])}, (u32x2*)(H + (size_t)row * DM + col));
#pragma unroll
            for (int j = 0; j < 4; ++j) {
                const u32x4 w0 = *(const u32x4*)(wg + (col + j) * 16), w1 = *(const u32x4*)(wg + (col + j) * 16 + 8);
#pragma unroll
                for (int q = 0; q < 4; ++q) { part[2 * q] += hv[j] * bflo(w0[q]); part[2 * q + 1] += hv[j] * bfhi(w0[q]); part[8 + 2 * q] += hv[j] * bflo(w1[q]); part[9 + 2 * q] += hv[j] * bfhi(w1[q]); }
            }
            __builtin_amdgcn_sched_barrier(0);
        }
#pragma unroll
        for (int n = 0; n < 16; ++n) part[n] = wave_sum(part[n]);
        {
            f32x4 z0 = bk0, z1 = bk1;
#pragma unroll
            for (int r = 0; r < 16; ++r) { const f32x4 wa = *(const f32x4*)(wk2 + r * 512 + 8 * lane), wb = *(const f32x4*)(wk2 + r * 512 + 8 * lane + 4); z0 += wa * part[r]; z1 += wb * part[r]; }
            float g[8];
#pragma unroll
            for (int j = 0; j < 4; ++j) { g[j] = -0.0625f * 0.6931471805599453f * __log2f(1.f + __expf(-z0[j])); g[4 + j] = -0.0625f * 0.6931471805599453f * __log2f(1.f + __expf(-z1[j])); }
            *(u32x4*)(GDEC + (size_t)row * 512 + 8 * lane) = (u32x4){pk2(g[0], g[1]), pk2(g[2], g[3]), pk2(g[4], g[5]), pk2(g[6], g[7])};
        }
        asm volatile("" :: "v"(pf));
    }
}

constexpr int RP = 136;
constexpr int VP = 72;
constexpr int OBP = 68;
__device__ __forceinline__ bf16x8 mk8(unsigned a, unsigned b, unsigned c, unsigned d) { return __builtin_bit_cast(bf16x8, (u32x4){a, b, c, d}); }

template <bool IS_A>
__device__ __forceinline__ void rec_finish(unsigned long long* GR, unsigned long long (&sg)[4], const int sib0, const int item, const int chunk, const int vj, const float ss_own,
                                           const f32x4 o0, const f32x4 o1, const f32x4 nw0, const f32x4 nw1, const u32x4 gate, bf16_t* dstp) {
    float total = ss_own;
#pragma unroll
    for (int k = 0; k < (IS_A ? 2 : 4); ++k) {
        if (sib0 + k == item) continue;
        unsigned long long x = sg[k];
        for (unsigned spins = 0; (unsigned)(x >> 32) != (unsigned)(chunk + 1) && spins < (1u << 22); ++spins) { __builtin_amdgcn_s_sleep(1); x = __hip_atomic_load(GR + ((size_t)(sib0 + k) * 32 + chunk) * 64 + vj, __ATOMIC_RELAXED, __HIP_MEMORY_SCOPE_AGENT); }
        total += __uint_as_float((unsigned)x);
    }
    const float rs = rsqrtf(total * (IS_A ? (1.f / 128.f) : (1.f / 256.f)) + EPS);
    const float g[8] = {bflo(gate[0]), bfhi(gate[0]), bflo(gate[1]), bfhi(gate[1]), bflo(gate[2]), bfhi(gate[2]), bflo(gate[3]), bfhi(gate[3])};
    float y[8];
#pragma unroll
    for (int j = 0; j < 4; ++j) { y[j] = o0[j] * rs * nw0[j] * siluf_(g[j]); y[4 + j] = o1[j] * rs * nw1[j] * siluf_(g[4 + j]); }
    __builtin_nontemporal_store((u32x4){pk2(y[0], y[1]), pk2(y[2], y[3]), pk2(y[4], y[5]), pk2(y[6], y[7])}, (u32x4*)dstp);
}
template <bool IS_A>
__device__ __forceinline__ void rec_item2(const Params& p, unsigned char* lds, const int item, const int b, const int h, const int es, const bool side_on, const int side_first, const int side_stride) {
    bf16_t* QL = (bf16_t*)lds; bf16_t* KD = QL + 64 * RP; bf16_t* KE = KD + 64 * RP; bf16_t* QI = KE + 64 * RP; bf16_t* XB = QI + 64 * RP;
    bf16_t* KDT = XB + 48 * RP;
    bf16_t* VT = KDT + 128 * VP;
    bf16_t* AT = VT + 64 * VP;
    float* T8 = (float*)(AT + 64 * VP);
    float* EB = T8 + 1024;
    float* GKl = EB + 128;
    float* OB = (float*)lds;
    bf16_t* TT = (bf16_t*)(lds + 128256);
    const int tid = opaque_tid(), lane = tid & 63, wave = __builtin_amdgcn_readfirstlane(tid >> 6), fr = lane & 15, fq = lane >> 4, dh = wave >> 2, eb = wave & 3;
    const bf16_t* PREC = (const bf16_t*)(p.ws + OFF_PREC);
    const bf16_t* GDEC = (const bf16_t*)(p.ws + OFF_GDEC);
    bf16_t* Y = (bf16_t*)p.out;
    unsigned long long* GR = (unsigned long long*)(p.ws + OFF_GRAN);
    const int sib0 = IS_A ? (item & ~1) : 128 + ((item - 128) & ~3);
    const int gcol = IS_A ? 3072 + h * 128 + es * 64 : 6144 + h * 256 + es * 64;
    const int qcol = IS_A ? h * 128 : 4096 + h * 128;
    const int kcol = IS_A ? 1024 + h * 128 : 4608 + h * 128;
    const int vcol = IS_A ? 2048 + h * 128 + es * 64 : 5120 + h * 256 + es * 64;
    const int ocol = IS_A ? h * 128 + es * 64 : 1024 + h * 256 + es * 64;
    const int d0 = 2 * lane, r0 = 8 * wave, sub = wave >> 1;
    const int vj = tid >> 3, ve8 = (tid & 7) * 8;
    const f32x4 nw0 = *(const f32x4*)((IS_A ? p.a_norm_w : p.b_norm_w) + es * 64 + ve8), nw1 = *(const f32x4*)((IS_A ? p.a_norm_w : p.b_norm_w) + es * 64 + ve8 + 4);
    const size_t row0 = (size_t)b * 2048;
    float lb0 = 0.f, lb1 = 0.f;
    if (IS_A) { const int ch = h * 128 + d0; lb0 = 1.f / (1.f + __expf(p.lb_param[1024 + ch] - p.lb_param[ch])); lb1 = 1.f / (1.f + __expf(p.lb_param[1025 + ch] - p.lb_param[ch + 1])); }
    f32x4 S[4];
#pragma unroll
    for (int i = 0; i < 4; ++i) S[i] = (f32x4){0.f, 0.f, 0.f, 0.f};
    for (int i = tid; i < 64 * VP / 2; i += 512) ((unsigned*)AT)[i] = 0u;
    unsigned qraw[8], kraw[8], graw[8]; u32x4 vraw;
#pragma unroll
    for (int r = 0; r < 8; ++r) { const bf16_t* pr = PREC + (row0 + r0 + r) * PREC_W; qraw[r] = *(const unsigned*)(pr + qcol + d0); kraw[r] = *(const unsigned*)(pr + kcol + d0);
        graw[r] = IS_A ? 0u : *(const unsigned*)(GDEC + (row0 + r0 + r) * 512 + h * 128 + d0); }
    vraw = *(const u32x4*)(PREC + (row0 + vj) * PREC_W + vcol + ve8);
    u32x4 gate_cur = *(const u32x4*)(PREC + (row0 + vj) * PREC_W + gcol + ve8), gate_nxt = gate_cur, gate_prev = gate_cur;
    f32x4 op0 = (f32x4){0.f, 0.f, 0.f, 0.f}, op1 = op0; float ss_prev = 0.f;
    unsigned long long sg[4] = {0ull, 0ull, 0ull, 0ull};
    __syncthreads();
    float sv[32]; TrTile stile; bool s_have = false;
    stile.sp = nullptr; stile.ldsrc = 0; stile.dst = nullptr; stile.K = 0;
#pragma unroll
    for (int i = 0; i < 32; ++i) sv[i] = 0.f;
    for (int c = 0; c < 32; ++c) {
        float q0[8], q1[8], k0[8], k1[8], P0[8], P1[8];
#pragma unroll
        for (int r = 0; r < 8; ++r) {
            q0[r] = bflo(qraw[r]); q1[r] = bfhi(qraw[r]);
            float a0, a1;
            if (IS_A) { a0 = lb0 + (1.f - lb0) * sigmoidf_(bflo(kraw[r])); a1 = lb1 + (1.f - lb1) * sigmoidf_(bfhi(kraw[r])); k0[r] = 1.f - a0; k1[r] = 1.f - a1; }
            else { a0 = __expf(bflo(graw[r])); a1 = __expf(bfhi(graw[r])); k0[r] = bflo(kraw[r]); k1[r] = bfhi(kraw[r]); }
            P0[r] = r ? P0[r - 1] * a0 : a0; P1[r] = r ? P1[r - 1] * a1 : a1;
        }
        *(float2*)(T8 + wave * 128 + d0) = make_float2(P0[7], P1[7]);
        __syncthreads();
        float T0[4], T1[4];
#pragma unroll
        for (int s = 0; s < 4; ++s) { const float2 x = *(const float2*)(T8 + (2 * s) * 128 + d0), y = *(const float2*)(T8 + (2 * s + 1) * 128 + d0); T0[s] = x.x * y.x; T1[s] = x.y * y.y; }
        float pre0 = 1.f, pre1 = 1.f;
        if (wave & 1) { const float2 x = *(const float2*)(T8 + (wave - 1) * 128 + d0); pre0 = x.x; pre1 = x.y; }
        float R0 = 1.f, R1 = 1.f, U0 = 1.f, U1 = 1.f, Ts0 = 1.f, Ts1 = 1.f;
#pragma unroll
        for (int s = 0; s < 4; ++s) { if (s < sub) { R0 *= T0[s]; R1 *= T1[s]; } if (s > sub) { U0 *= T0[s]; U1 *= T1[s]; } if (s == sub) { Ts0 = T0[s]; Ts1 = T1[s]; } }
        if (wave == 0) *(float2*)(EB + d0) = make_float2(T0[0] * T0[1] * T0[2] * T0[3], T1[0] * T1[1] * T1[2] * T1[3]);
        unsigned kdc0[4], kdc1[4];
        float kprev0 = 0.f, kprev1 = 0.f;
#pragma unroll
        for (int r = 0; r < 8; ++r) {
            const int i = r0 + r;
            const float pl0 = pre0 * P0[r], pl1 = pre1 * P1[r];
            const float iv0 = __builtin_amdgcn_rcpf(pl0), iv1 = __builtin_amdgcn_rcpf(pl1);
            const float ql0 = q0[r] * pl0, ql1 = q1[r] * pl1;
            const float kd0 = k0[r] * iv0, kd1 = k1[r] * iv1;
            const float ke0 = kd0 * Ts0, ke1 = kd1 * Ts1;
            *(unsigned*)(QL + i * RP + d0) = pk2(ql0, ql1);
            *(unsigned*)(QI + i * RP + d0) = pk2(ql0 * R0, ql1 * R1);
            *(unsigned*)(KD + i * RP + d0) = pk2(kd0, kd1);
            *(unsigned*)(KE + i * RP + d0) = pk2(ke0, ke1);
            if (sub == 2) *(unsigned*)(XB + (i - 32) * RP + d0) = pk2(ql0 * T0[1], ql1 * T1[1]);
            if (sub == 3) { *(unsigned*)(XB + (16 + i - 48) * RP + d0) = pk2(ql0 * T0[2], ql1 * T1[2]); *(unsigned*)(XB + (32 + i - 48) * RP + d0) = pk2(ql0 * (T0[1] * T0[2]), ql1 * (T1[1] * T1[2])); }
            const float kc0 = ke0 * U0, kc1 = ke1 * U1;
            if (r & 1) { kdc0[r >> 1] = pk2(kprev0, kc0); kdc1[r >> 1] = pk2(kprev1, kc1); } else { kprev0 = kc0; kprev1 = kc1; }
        }
        *(u32x4*)(KDT + d0 * VP + r0) = (u32x4){kdc0[0], kdc0[1], kdc0[2], kdc0[3]};
        *(u32x4*)(KDT + (d0 + 1) * VP + r0) = (u32x4){kdc1[0], kdc1[1], kdc1[2], kdc1[3]};
#pragma unroll
        for (int q = 0; q < 4; ++q) { VT[(ve8 + 2 * q) * VP + vj] = (bf16_t)(vraw[q] & 0xffffu); VT[(ve8 + 2 * q + 1) * VP + vj] = (bf16_t)(vraw[q] >> 16); }
        if (s_have) tr_to_lds(TT, sv, tid);
        const bool s_store = s_have; const TrTile s_prev = stile;
        {   const int lt = side_first + c * side_stride;
            s_have = side_on && lt < LT_TOTAL;
            if (s_have) { stile = later_tile(p, lt, tid); tr_load(stile, sv); } }
        if (c + 1 < 32) {
            const size_t rn = row0 + (size_t)(c + 1) * 64;
#pragma unroll
            for (int r = 0; r < 8; ++r) { const bf16_t* pr = PREC + (rn + r0 + r) * PREC_W; qraw[r] = *(const unsigned*)(pr + qcol + d0); kraw[r] = *(const unsigned*)(pr + kcol + d0);
                if (!IS_A) graw[r] = *(const unsigned*)(GDEC + (rn + r0 + r) * 512 + h * 128 + d0); }
            vraw = *(const u32x4*)(PREC + (rn + vj) * PREC_W + vcol + ve8);
            gate_nxt = *(const u32x4*)(PREC + (rn + vj) * PREC_W + gcol + ve8);
        }
        __syncthreads();
        if (s_store) tr_store(TT, s_prev, tid);
        if (c > 0) {
#pragma unroll
            for (int k = 0; k < (IS_A ? 2 : 4); ++k) sg[k] = __hip_atomic_load(GR + ((size_t)(sib0 + k) * 32 + (c - 1)) * 64 + vj, __ATOMIC_RELAXED, __HIP_MEMORY_SCOPE_AGENT); }
        f32x4 op[4];
#pragma unroll
        for (int ib = 0; ib < 4; ++ib) op[ib] = (f32x4){0.f, 0.f, 0.f, 0.f};
#pragma unroll
        for (int ks = 0; ks < 2; ++ks) {
            const bf16x8 Bs = mk8(pk2(S[2 * ks][0], S[2 * ks][1]), pk2(S[2 * ks][2], S[2 * ks][3]), pk2(S[2 * ks + 1][0], S[2 * ks + 1][1]), pk2(S[2 * ks + 1][2], S[2 * ks + 1][3]));
#pragma unroll
            for (int ib = 0; ib < 4; ++ib) {
                const bf16_t* qa = QI + (16 * ib + fr) * RP + 64 * dh + 32 * ks + 4 * fq;
                const u32x2 lo = *(const u32x2*)qa, hi = *(const u32x2*)(qa + 16);
                op[ib] = __builtin_amdgcn_mfma_f32_16x16x32_bf16(mk8(lo[0], lo[1], hi[0], hi[1]), Bs, op[ib], 0, 0, 0);
            }
        }
        for (int bi = wave; bi < 10; bi += 8) {
            const int s = bi >= 6 ? 3 : (bi >= 3 ? 2 : (bi >= 1 ? 1 : 0)), r = bi - (s * (s + 1)) / 2, diff = s - r;
            const bf16_t *Ab, *Bb;
            if (diff == 0) { Ab = QL + 16 * s * RP; Bb = KD + 16 * r * RP; }
            else if (diff == 1) { Ab = QL + 16 * s * RP; Bb = KE + 16 * r * RP; }
            else if (diff == 2) { Ab = XB + (s == 2 ? 0 : 16) * RP; Bb = KE + 16 * r * RP; }
            else { Ab = XB + 32 * RP; Bb = KE; }
            f32x4 at = (f32x4){0.f, 0.f, 0.f, 0.f};
#pragma unroll
            for (int ks = 0; ks < 4; ++ks) {
                const bf16x8 av = *(const bf16x8*)(Ab + fr * RP + 32 * ks + 8 * fq), bv = *(const bf16x8*)(Bb + fr * RP + 32 * ks + 8 * fq);
                at = __builtin_amdgcn_mfma_f32_16x16x32_bf16(av, bv, at, 0, 0, 0);
            }
#pragma unroll
            for (int jj = 0; jj < 4; ++jj) { float v = at[jj]; if (diff == 0 && fr > 4 * fq + jj) v = 0.f; AT[(16 * s + 4 * fq + jj) * VP + 16 * r + fr] = (bf16_t)(pk2(v, 0.f) & 0xffffu); }
        }
        __syncthreads();
        {   const bf16x8 bv = *(const bf16x8*)(VT + (16 * eb + fr) * VP + 32 * dh + 8 * fq);
#pragma unroll
            for (int ib = 0; ib < 4; ++ib) {
                if (dh == 1 && ib < 2) continue;
                const bf16x8 av = *(const bf16x8*)(AT + (16 * ib + fr) * VP + 32 * dh + 8 * fq);
                op[ib] = __builtin_amdgcn_mfma_f32_16x16x32_bf16(av, bv, op[ib], 0, 0, 0);
            }
        }
#pragma unroll
        for (int ib = 0; ib < 4; ++ib)
#pragma unroll
            for (int jj = 0; jj < 4; ++jj) OB[(dh * 64 + 16 * ib + 4 * fq + jj) * OBP + 16 * eb + fr] = op[ib][jj];
#pragma unroll
        for (int dt = 0; dt < 4; ++dt) {
            const f32x4 ebv = *(const f32x4*)(EB + 64 * dh + 16 * dt + 4 * fq);
            S[dt] = S[dt] * ebv;
#pragma unroll
            for (int ks = 0; ks < 2; ++ks) {
                const bf16x8 av = *(const bf16x8*)(KDT + (64 * dh + 16 * dt + fr) * VP + 32 * ks + 8 * fq), bv = *(const bf16x8*)(VT + (16 * eb + fr) * VP + 32 * ks + 8 * fq);
                S[dt] = __builtin_amdgcn_mfma_f32_16x16x32_bf16(av, bv, S[dt], 0, 0, 0);
            }
        }
        __syncthreads();
        {   const float* o0 = OB + vj * OBP + ve8; const float* o1 = OB + (64 + vj) * OBP + ve8;
            const f32x4 a0 = *(const f32x4*)o0 + *(const f32x4*)o1, a1 = *(const f32x4*)(o0 + 4) + *(const f32x4*)(o1 + 4);
            float ss = a0[0] * a0[0] + a0[1] * a0[1] + a0[2] * a0[2] + a0[3] * a0[3] + a1[0] * a1[0] + a1[1] * a1[1] + a1[2] * a1[2] + a1[3] * a1[3];
            ss += __shfl_xor(ss, 1); ss += __shfl_xor(ss, 2); ss += __shfl_xor(ss, 4);
            if ((tid & 7) == 0) __hip_atomic_store(GR + ((size_t)item * 32 + c) * 64 + vj, ((unsigned long long)(unsigned)(c + 1) << 32) | (unsigned long long)__float_as_uint(ss), __ATOMIC_RELAXED, __HIP_MEMORY_SCOPE_AGENT);
            if (c > 0) rec_finish<IS_A>(GR, sg, sib0, item, c - 1, vj, ss_prev, op0, op1, nw0, nw1, gate_prev, Y + (row0 + (size_t)(c - 1) * 64 + vj) * DM + ocol + ve8);
            op0 = a0; op1 = a1; ss_prev = ss; gate_prev = gate_cur; gate_cur = gate_nxt;
        }
        __syncthreads();
    }
    {
#pragma unroll
        for (int k = 0; k < (IS_A ? 2 : 4); ++k) sg[k] = __hip_atomic_load(GR + ((size_t)(sib0 + k) * 32 + 31) * 64 + vj, __ATOMIC_RELAXED, __HIP_MEMORY_SCOPE_AGENT);
        rec_finish<IS_A>(GR, sg, sib0, item, 31, vj, ss_prev, op0, op1, nw0, nw1, gate_prev, Y + (row0 + (size_t)31 * 64 + vj) * DM + ocol + ve8);
    }
    if (s_have) { tr_to_lds(TT, sv, tid); __syncthreads(); tr_store(TT, stile, tid); __syncthreads(); }
}
__device__ __forceinline__ void phase_rec2(const Params& p, unsigned char* lds) {
    int nitem = 0;
    for (int item = blockIdx.x; item < 256; item += gridDim.x, ++nitem) {
        if (item < 128) { const int seq = item >> 1; rec_item2<true>(p, lds, item, seq >> 3, seq & 7, item & 1, nitem == 0, (int)blockIdx.x, (int)gridDim.x); }
        else { const int w = item - 128, seq = w >> 2; rec_item2<false>(p, lds, item, seq >> 2, seq & 3, w & 3, nitem == 0, (int)blockIdx.x, (int)gridDim.x); }
    }
    const int tid = opaque_tid();
    for (int lt = (nitem ? (int)blockIdx.x + 32 * (int)gridDim.x : (int)blockIdx.x); lt < LT_TOTAL; lt += gridDim.x) {
        float v[32]; const TrTile t = later_tile(p, lt, tid); tr_load(t, v); tr_to_lds((bf16_t*)(lds + 128256), v, tid); __syncthreads(); tr_store((const bf16_t*)(lds + 128256), t, tid); __syncthreads();
    }
}

__device__ __forceinline__ void phase_y(const Params& p) {
    const int tid = opaque_tid(), lane = tid & 63, wave = tid >> 6;
    const bf16_t* PREC = (const bf16_t*)(p.ws + OFF_PREC);
    const bf16_t* O = (const bf16_t*)p.out + (size_t)NTOK * DM; bf16_t* Y = (bf16_t*)p.out;
    const int rstep = gridDim.x * 8;
    int row = blockIdx.x * 8 + wave;
    u32x4 ov[4], gv[4], on[4], gn[4];
    if (row < NTOK) {
#pragma unroll
        for (int i = 0; i < 4; ++i) { const int col = 512 * i + 8 * lane; ov[i] = *(const u32x4*)(O + (size_t)row * DM + col); gv[i] = *(const u32x4*)(PREC + (size_t)row * PREC_W + (i < 2 ? 3072 + col : 6144 + col - 1024)); }
    }
    for (; row < NTOK; row += rstep) {
        const int rnext = row + rstep < NTOK ? row + rstep : row;
#pragma unroll
        for (int i = 0; i < 4; ++i) { const int col = 512 * i + 8 * lane; on[i] = *(const u32x4*)(O + (size_t)rnext * DM + col); gn[i] = *(const u32x4*)(PREC + (size_t)rnext * PREC_W + (i < 2 ? 3072 + col : 6144 + col - 1024)); }
#pragma unroll
        for (int i = 0; i < 4; ++i) {
            const int col = 512 * i + 8 * lane;
            float o[8] = {bflo(ov[i][0]), bfhi(ov[i][0]), bflo(ov[i][1]), bfhi(ov[i][1]), bflo(ov[i][2]), bfhi(ov[i][2]), bflo(ov[i][3]), bfhi(ov[i][3])};
            float ss = 0.f;
#pragma unroll
            for (int j = 0; j < 8; ++j) ss += o[j] * o[j];
            ss += __shfl_xor(ss, 1); ss += __shfl_xor(ss, 2); ss += __shfl_xor(ss, 4); ss += __shfl_xor(ss, 8);
            float rs; const float* nw;
            if (i < 2) { rs = rsqrtf(ss * (1.f / 128.f) + EPS); nw = p.a_norm_w + (col & 127); }
            else { ss += __shfl_xor(ss, 16); rs = rsqrtf(ss * (1.f / 256.f) + EPS); nw = p.b_norm_w + ((col - 1024) & 255); }
            const f32x4 w0 = *(const f32x4*)nw, w1 = *(const f32x4*)(nw + 4);
            const float g[8] = {bflo(gv[i][0]), bfhi(gv[i][0]), bflo(gv[i][1]), bfhi(gv[i][1]), bflo(gv[i][2]), bfhi(gv[i][2]), bflo(gv[i][3]), bfhi(gv[i][3])};
            float y[8];
#pragma unroll
            for (int j = 0; j < 4; ++j) { y[j] = o[j] * rs * w0[j] * siluf_(g[j]); y[4 + j] = o[4 + j] * rs * w1[j] * siluf_(g[4 + j]); }
            __builtin_nontemporal_store((u32x4){pk2(y[0], y[1]), pk2(y[2], y[3]), pk2(y[4], y[5]), pk2(y[6], y[7])}, (u32x4*)(Y + (size_t)row * DM + col));
        }
#pragma unroll
        for (int i = 0; i < 4; ++i) { ov[i] = on[i]; gv[i] = gn[i]; }
    }
}

__device__ __forceinline__ void phase_h2(const Params& p) {
    const int tid = opaque_tid(), lane = tid & 63, wave = tid >> 6;
    const float* MOD = (const float*)(p.ws + OFF_MOD); bf16_t* H2 = (bf16_t*)p.out; const bf16_t* X1 = (const bf16_t*)(p.ws + OFF_PM);
    const int rstep = gridDim.x * 8;
    int row = blockIdx.x * 8 + wave;
    u32x2 xv[8], xn[8];
    if (row < NTOK) {
#pragma unroll
        for (int i = 0; i < 8; ++i) xv[i] = *(const u32x2*)(X1 + (size_t)row * MP + i * 256 + lane * 4);
    }
    for (; row < NTOK; row += rstep) {
        const int b = row >> 11;
        const int rnext = row + rstep < NTOK ? row + rstep : row;
#pragma unroll
        for (int i = 0; i < 8; ++i) xn[i] = *(const u32x2*)(X1 + (size_t)rnext * MP + i * 256 + lane * 4);
        f32x4 x[8]; float ss = 0.f;
#pragma unroll
        for (int i = 0; i < 8; ++i) { x[i] = (f32x4){bflo(xv[i][0]), bfhi(xv[i][0]), bflo(xv[i][1]), bfhi(xv[i][1])}; ss += x[i][0] * x[i][0] + x[i][1] * x[i][1] + x[i][2] * x[i][2] + x[i][3] * x[i][3]; }
        ss = wave_sum(ss);
        const float rstd = rsqrtf(ss * (1.f / 2048.f) + EPS);
#pragma unroll
        for (int i = 0; i < 8; ++i) {
            const int col = i * 256 + lane * 4;
            const f32x4 w = *(const f32x4*)(p.norm2_w + col), sc = *(const f32x4*)(MOD + (size_t)b * NMOD + 8192 + col), sh = *(const f32x4*)(MOD + (size_t)b * NMOD + 6144 + col);
            f32x4 hv;
#pragma unroll
            for (int j = 0; j < 4; ++j) hv[j] = x[i][j] * rstd * w[j] * (1.f + sc[j]) + sh[j];
            __builtin_nontemporal_store((u32x2){pk2(hv[0], hv[1]), pk2(hv[2], hv[3])}, (u32x2*)(H2 + (size_t)row * DM + col));
        }
#pragma unroll
        for (int i = 0; i < 8; ++i) xv[i] = xn[i];
    }
}
__device__ __forceinline__ void phase_final(const Params& p) {
    const int tid = opaque_tid(), lane = tid & 63, wave = tid >> 6;
    const bf16_t* X2 = (const bf16_t*)(p.ws + OFF_PM);
    const int rstep = gridDim.x * 8;
    int row = blockIdx.x * 8 + wave;
    u32x2 xv[8], xn[8];
    if (row < NTOK) {
#pragma unroll
        for (int i = 0; i < 8; ++i) xv[i] = *(const u32x2*)(X2 + (size_t)row * MP + i * 256 + lane * 4);
    }
    for (; row < NTOK; row += rstep) {
        const int rnext = row + rstep < NTOK ? row + rstep : row;
#pragma unroll
        for (int i = 0; i < 8; ++i) xn[i] = *(const u32x2*)(X2 + (size_t)rnext * MP + i * 256 + lane * 4);
        f32x4 x[8]; float ss = 0.f;
#pragma unroll
        for (int i = 0; i < 8; ++i) { x[i] = (f32x4){bflo(xv[i][0]), bfhi(xv[i][0]), bflo(xv[i][1]), bfhi(xv[i][1])}; ss += x[i][0] * x[i][0] + x[i][1] * x[i][1] + x[i][2] * x[i][2] + x[i][3] * x[i][3]; }
        ss = wave_sum(ss);
        const float rstd = rsqrtf(ss * (1.f / 2048.f) + EPS);
        float* xr = p.out + (size_t)row * DM;
#pragma unroll
        for (int i = 0; i < 8; ++i) {
            const int col = i * 256 + lane * 4;
            const f32x4 w = *(const f32x4*)(p.final_norm_w + col);
            __builtin_nontemporal_store(x[i] * rstd * w, (f32x4*)(xr + col));
        }
#pragma unroll
        for (int i = 0; i < 8; ++i) xv[i] = xn[i];
    }
}

#define XB_TMO      128
#define XB_XCNT(j)  (256  + 64 * (j))
#define XB_XSUB(j)  (1280 + 64 * (j))
#define XB_XGEN(j)  (2304 + 64 * (j))
#define XB_TOP      3328
#define XB_TOPGEN   3392
#define XCD_BAR_WORDS 3456
#define XB_SPIN_CAP (1u << 20)
__device__ __forceinline__ unsigned xb_ld(unsigned* p)              { return __hip_atomic_load(p, __ATOMIC_RELAXED, __HIP_MEMORY_SCOPE_AGENT); }
__device__ __forceinline__ unsigned xb_add(unsigned* p, unsigned v) { return __hip_atomic_fetch_add(p, v, __ATOMIC_RELAXED, __HIP_MEMORY_SCOPE_AGENT); }
__device__ __forceinline__ unsigned xb_xcc_id() { return (unsigned)__builtin_amdgcn_s_getreg((3 << 11) | 20) & 0xFu; }
#define XB_SPIN(cond, bar) do { unsigned _sp = 0; while (cond) { __builtin_amdgcn_s_sleep(1); \
    if ((++_sp & 255u) == 0u) { if (xb_ld(&(bar)[XB_TMO])) break; if (_sp > XB_SPIN_CAP) { atomicAdd(&(bar)[XB_TMO], 1u); break; } } } } while (0)
struct XcdBarrier { unsigned* bar; unsigned x; volatile LAS unsigned* st; };
__device__ __forceinline__ XcdBarrier xcd_barrier_post(unsigned* bar, volatile LAS unsigned* st) {
    XcdBarrier b; b.bar = bar; b.x = xb_xcc_id(); b.st = st;
    if (threadIdx.x == 0) (void)xb_add(&bar[XB_XCNT(b.x)], 1u);
    return b;
}
__device__ __forceinline__ void xcd_barrier_complete(unsigned* bar, unsigned x, unsigned& nloc, unsigned& nx) {
    const unsigned G = gridDim.x * gridDim.y * gridDim.z;
    unsigned sum, cnt, mine, sp = 0u;
    for (;;) {
        sum = 0u; cnt = 0u; mine = 0u;
#pragma unroll
        for (unsigned j = 0; j < 16; ++j) { const unsigned c = xb_ld(&bar[XB_XCNT(j)]); sum += c; cnt += (c > 0u) ? 1u : 0u; mine = (j == x) ? c : mine; }
        if (sum == G) break;
        __builtin_amdgcn_s_sleep(1);
        if ((++sp & 255u) == 0u) { if (xb_ld(&bar[XB_TMO])) break; if (sp > XB_SPIN_CAP) { atomicAdd(&bar[XB_TMO], 1u); break; } }
    }
    nloc = mine > 0u ? mine : 1u; nx = cnt > 0u ? cnt : 1u;
}
__device__ __forceinline__ void xcd_barrier(const XcdBarrier& b) {
    asm volatile("s_waitcnt vmcnt(0)" ::: "memory");
    __syncthreads();
    if (threadIdx.x == 0) {
        unsigned* bar = b.bar;
        __builtin_amdgcn_s_waitcnt(0);
        unsigned nloc = b.st[0], nx = b.st[1];
        if (nloc == 0u) { xcd_barrier_complete(bar, b.x, nloc, nx); b.st[0] = nloc; b.st[1] = nx; }
        const unsigned old = xb_add(&bar[XB_XSUB(b.x)], 1u);
        const unsigned gen = old / nloc;
        if (old + 1u == (gen + 1u) * nloc) {
            __builtin_amdgcn_fence(__ATOMIC_RELEASE, "agent");
            asm volatile("s_waitcnt vmcnt(0)" ::: "memory");
            const unsigned og = xb_add(&bar[XB_TOP], 1u);
            const unsigned tg = og / nx;
            if (og + 1u == (tg + 1u) * nx) xb_add(&bar[XB_TOPGEN], 1u);
            else XB_SPIN(xb_ld(&bar[XB_TOPGEN]) == tg, bar);
            __builtin_amdgcn_fence(__ATOMIC_ACQUIRE, "agent");
            xb_add(&bar[XB_XGEN(b.x)], 1u);
            asm volatile("s_waitcnt vmcnt(0)" ::: "memory");
        } else {
            XB_SPIN(xb_ld(&bar[XB_XGEN(b.x)]) == gen, bar);
            __builtin_amdgcn_fence(__ATOMIC_ACQUIRE, "agent");
            asm volatile("s_waitcnt vmcnt(0)" ::: "memory");
        }
    }
    __syncthreads();
}

__device__ __forceinline__ pg8::Sched make_sched(int nN, int pairs, const void* A0, const void* A1, size_t atile, const void* B0, const void* B1, size_t btile) {
    pg8::Sched S; S.nM = NTOK / 256; S.nN = nN; S.nwg = S.nM * nN; S.G = gridDim.x; S.c = blockIdx.x; S.pairs = pairs;
    S.A0 = (const char*)A0; S.A1 = (const char*)A1; S.B0 = (const char*)B0; S.B1 = (const char*)B1; S.atile = atile; S.btile = btile; return S;
}

__global__ void __launch_bounds__(512, 2) fwd_kernel(const Params p) {
    extern __shared__ __attribute__((aligned(16))) unsigned char shm[];
    cg::grid_group grid = cg::this_grid();
    LAS unsigned char* lds = (LAS unsigned char*)shm;
    unsigned char* ws = p.ws;
    volatile LAS unsigned* xst = (volatile LAS unsigned*)(lds + XST_OFF);
    if (threadIdx.x == 0) { xst[0] = 0u; xst[1] = 0u; }
    __syncthreads();
    const XcdBarrier xb = xcd_barrier_post((unsigned*)(ws + OFF_BAR), xst);
    if (p.phase_hi > NPHASE) grid.sync();
#if USE_CG_SYNC
#define GSYNC() grid.sync()
#else
#define GSYNC() xcd_barrier(xb)
#endif
#ifndef PH_MASK
#define PH_MASK 0x7ff
#endif
#ifndef REPEAT_MASK
#define REPEAT_MASK 0
#endif
#define PHASE(n) if ((((PH_MASK) >> (n)) & 1) && p.phase_lo <= (n) && (n) < p.phase_hi) { if ((n) > p.phase_lo) GSYNC(); for (int rep_ = 0; rep_ <= (((REPEAT_MASK) >> (n)) & 1); ++rep_) { if (rep_) GSYNC();
#define PHASE_END } }
    PHASE(0) phase_prep(p, shm); PHASE_END
    PHASE(1) phase_h(p, shm); PHASE_END
    PHASE(2) { const pg8::Sched S = make_sched(44, 0, p.out, p.out, (size_t)256 * DM * 2, ws + OFF_WT_IN, ws + OFF_WT_IN, (size_t)256 * 2048 * 2);
               EpiG1 E; E.prec = (bf16_t*)(ws + OFF_PREC); E.pm_ = (bf16_t*)(ws + OFF_PM);
               pg8::gemm_phase(lds, 2048, DM, 2048, S, E); } PHASE_END
        PHASE(3) phase_rec2(p, shm); PHASE_END
    PHASE(5) { const pg8::Sched S = make_sched(8, 1, p.out, (const char*)p.out + 1024 * 2, (size_t)256 * DM * 2, ws + OFF_WT_UPA, ws + OFF_WT_UPB, (size_t)256 * 1024 * 2);
               EpiG2 E; E.merged = (bf16_t*)(ws + OFF_PREC); E.pm_ = (const bf16_t*)(ws + OFF_PM);
               pg8::gemm_phase(lds, 1024, DM, 1024, S, E); } PHASE_END
    PHASE(6) { const pg8::Sched S = make_sched(8, 0, ws + OFF_PREC, ws + OFF_PREC, (size_t)256 * DM * 2, ws + OFF_WT_O, ws + OFF_WT_O, (size_t)256 * 2048 * 2);
               EpiResT<false> E; E.xin = p.x; E.ldi = DM; E.xout = (bf16_t*)(ws + OFF_PM); E.ldo = MP; E.gt = (const float*)(ws + OFF_MOD) + 4096;
               pg8::gemm_phase(lds, 2048, DM, 2048, S, E); } PHASE_END
    PHASE(7) phase_h2(p); PHASE_END
    PHASE(8) { const pg8::Sched S = make_sched(44, 0, p.out, p.out, (size_t)256 * DM * 2, ws + OFF_WT_FFI, ws + OFF_WT_FFI, (size_t)256 * 2048 * 2);
               EpiG4 E; E.actb = (bf16_t*)(ws + OFF_PREC);
               pg8::gemm_phase(lds, 2048, DM, 2048, S, E); } PHASE_END
    PHASE(9) { const pg8::Sched S = make_sched(8, 0, ws + OFF_PREC, ws + OFF_PREC, (size_t)256 * FFH * 2, ws + OFF_WT_FFO, ws + OFF_WT_FFO, (size_t)256 * FFH * 2);
               EpiResT<true> E; E.xin = ws + OFF_PM; E.ldi = MP; E.xout = (bf16_t*)(ws + OFF_PM); E.ldo = MP; E.gt = (const float*)(ws + OFF_MOD) + 10240;
               pg8::gemm_phase(lds, FFH, FFH, FFH, S, E); } PHASE_END
    PHASE(10) phase_final(p); PHASE_END
#ifndef EXTRA_SYNCS
#define EXTRA_SYNCS 0
#endif
    for (int i = 0; i < EXTRA_SYNCS; ++i) GSYNC();
#undef PHASE
#undef PHASE_END
}

extern "C" void kernel_launch(void* const* d_in, const int* in_sizes, int n_in, void* d_out, int out_size, void* d_ws, size_t ws_size, hipStream_t stream) {
    static int grid = 0;
    if (grid == 0) {
        if (n_in != 18 || ws_size < WS_END) { fprintf(stderr, "kernel_launch: need 18 inputs and >= %zu bytes of workspace; got %d, %zu\n", (size_t)WS_END, n_in, ws_size); grid = -1; return; }
        int dev = 0, cus = 0, per_cu = 0;
        hipGetDevice(&dev);
        hipDeviceGetAttribute(&cus, hipDeviceAttributeMultiprocessorCount, dev);
        if (hipFuncSetAttribute((const void*)fwd_kernel, hipFuncAttributeMaxDynamicSharedMemorySize, LDS_BYTES) != hipSuccess) fprintf(stderr, "kernel_launch: hipFuncSetAttribute failed\n");
        if (hipOccupancyMaxActiveBlocksPerMultiprocessor(&per_cu, (const void*)fwd_kernel, 512, LDS_BYTES) != hipSuccess || per_cu < 1) { fprintf(stderr, "kernel_launch: occupancy query says %d\n", per_cu); per_cu = 1; }
        (void)hipGetLastError();
        grid = cus * 1;
    }
    if (grid < 0) return;
    (void)hipMemsetAsync((unsigned char*)d_ws + OFF_BAR, 0, BAR_BYTES, stream);
    Params p{};
    p.x = (const float*)d_in[0]; p.c = (const float*)d_in[1]; p.w_ada = (const float*)d_in[2]; p.b_ada = (const float*)d_in[3]; p.norm1_w = (const float*)d_in[4];
    p.w_in = (const float*)d_in[5]; p.w_gk2 = (const float*)d_in[6]; p.b_gk2 = (const float*)d_in[7]; p.lb_param = (const float*)d_in[8]; p.a_norm_w = (const float*)d_in[9];
    p.b_norm_w = (const float*)d_in[10]; p.w_up_a = (const float*)d_in[11]; p.w_up_b = (const float*)d_in[12]; p.w_o = (const float*)d_in[13]; p.norm2_w = (const float*)d_in[14];
    p.w_ffn_in = (const float*)d_in[15]; p.w_ffn_out = (const float*)d_in[16]; p.final_norm_w = (const float*)d_in[17];
    p.out = (float*)d_out; p.ws = (unsigned char*)d_ws;
#if ONE_LAUNCH
    p.phase_lo = 0; p.phase_hi = NPHASE;
    void* args[] = {(void*)&p};
    hipError_t e = hipLaunchCooperativeKernel((const void*)fwd_kernel, dim3(grid), dim3(512), args, LDS_BYTES, stream);
    if (e != hipSuccess) fprintf(stderr, "cooperative launch failed: %s (grid %d)\n", hipGetErrorString(e), grid);
#else
    for (int ph = 0; ph < NPHASE; ++ph) {
        p.phase_lo = ph; p.phase_hi = ph + 1;
        hipLaunchKernelGGL(fwd_kernel, dim3(grid), dim3(512), LDS_BYTES, stream, p);
    }
#endif
}
```

```cpp
#include <hip/hip_runtime.h>
#include <hip/hip_cooperative_groups.h>
#include <cstdio>
#include <cstdint>
namespace cg = cooperative_groups;

#ifndef ONE_LAUNCH
#define ONE_LAUNCH 1
#endif
#ifndef USE_CG_SYNC
#define USE_CG_SYNC 0
#endif
#ifndef NAIVE_GEMM
#define NAIVE_GEMM 0
#endif

#define LAS __attribute__((address_space(3)))
typedef unsigned short bf16_t;
typedef short bf16x8 __attribute__((ext_vector_type(8)));
typedef float f32x4 __attribute__((ext_vector_type(4)));
typedef unsigned u32x4 __attribute__((ext_vector_type(4)));
typedef unsigned u32x2 __attribute__((ext_vector_type(2)));

constexpr int NTOK = 16384, DM = 2048;
constexpr int PREC_W = 7168, PM_W = 4096 + 64, FFH = 5632, INW = 11280, NMOD = 12288;
constexpr float EPS = 1e-6f;
constexpr int XST_OFF = 163072;
constexpr int XP = 2048 + 32;
constexpr int MP = 2048 + 64;
constexpr int LDS_BYTES = XST_OFF + 64;
constexpr int NPHASE = 11;

constexpr size_t OFF_WT_IN  = 0;
constexpr size_t OFF_WT_UPA = OFF_WT_IN + (size_t)11264 * 2048 * 2;
constexpr size_t OFF_WT_UPB = OFF_WT_UPA + (size_t)2048 * 1024 * 2;
constexpr size_t OFF_WT_O   = OFF_WT_UPB + (size_t)2048 * 1024 * 2;
constexpr size_t OFF_WT_FFI = OFF_WT_O + (size_t)2048 * 2048 * 2;
constexpr size_t OFF_WT_FFO = OFF_WT_FFI + (size_t)11264 * 2048 * 2;
constexpr size_t OFF_MOD    = OFF_WT_FFO + (size_t)2048 * 5632 * 2;
constexpr size_t OFF_GKL    = OFF_MOD + (size_t)8 * 12288 * 4;
constexpr size_t OFF_PREC   = OFF_GKL + (size_t)16384 * 16 * 4;
constexpr size_t OFF_PM     = OFF_PREC + (size_t)16384 * 7168 * 2;
constexpr size_t OFF_BAR    = OFF_PM + (size_t)16384 * PM_W * 2;
constexpr size_t BAR_BYTES  = 16384;
constexpr size_t OFF_GDEC   = OFF_BAR + BAR_BYTES;
constexpr size_t OFF_GRAN   = OFF_GDEC + (size_t)16384 * 512 * 2;
constexpr size_t GRAN_BYTES = (size_t)256 * 32 * 64 * 8;
constexpr size_t WS_END     = OFF_GRAN + GRAN_BYTES;

struct Params {
    const float *x, *c, *w_ada, *b_ada, *norm1_w, *w_in, *w_gk2, *b_gk2, *lb_param, *a_norm_w, *b_norm_w, *w_up_a, *w_up_b, *w_o, *norm2_w, *w_ffn_in, *w_ffn_out, *final_norm_w;
    float* out; unsigned char* ws;
    int phase_lo, phase_hi;
};

__device__ __forceinline__ unsigned pk2(float lo, float hi) { unsigned r; asm("v_cvt_pk_bf16_f32 %0, %1, %2" : "=v"(r) : "v"(lo), "v"(hi)); return r; }
__device__ __forceinline__ float bflo(unsigned u) { return __uint_as_float(u << 16); }
__device__ __forceinline__ float bfhi(unsigned u) { return __uint_as_float(u & 0xffff0000u); }
__device__ __forceinline__ float bf1(bf16_t b) { return __uint_as_float(((unsigned)b) << 16); }
__device__ __forceinline__ float sigmoidf_(float v) { return __builtin_amdgcn_rcpf(1.f + __expf(-v)); }
__device__ __forceinline__ float siluf_(float v) { return v * sigmoidf_(v); }
__device__ __forceinline__ int opaque_tid() { int t = threadIdx.x; asm volatile("" : "+v"(t)); return t; }
__device__ __forceinline__ float wave_sum(float v) {
#pragma unroll
    for (int o = 1; o < 64; o <<= 1) v += __shfl_xor(v, o);
    return v;
}

namespace pg8 {
constexpr int BM = 256, BK = 64, HALF = 128, HTB = HALF * BK * 2, STAGE_BYTES = 8 * HTB, NXCD = 8, WGM = 8;
__host__ __device__ __forceinline__ int lds_byte(int r, int c) { const int st = (r >> 4) * 2 + (c >> 5), rr = r & 15, cc = c & 31, ob = rr * 64 + cc * 2; return st * 1024 + (ob ^ (((ob >> 9) & 1) << 5)); }
__host__ __device__ __forceinline__ void stage_rc(int b, int& R, int& C) { const int st = b / 1024, sb = b % 1024, swz = sb ^ (((sb >> 9) & 1) << 5); R = (st >> 1) * 16 + swz / 64; C = (st & 1) * 32 + (swz % 64) / 2; }
__host__ __device__ __forceinline__ int perm32(int rho) { const int n = rho >> 4, i = rho & 15; return 8 * (i >> 2) + 4 * n + (i & 3); }

struct Unit { int pm, pn, aux; const char* A; const char* B; };

struct Sched {
    int nM, nN, nwg, G, c, pairs;
    const char *A0, *A1, *B0, *B1; size_t atile, btile;
    __device__ __forceinline__ bool next(int i, Unit& u) const {
        const int ti = pairs ? (i >> 1) : i, s = pairs ? (i & 1) : 0;
        const long L = (long)ti * G + c; if (L >= nwg) return false;
        int wgid = (int)L; { const int q = nwg / NXCD, r = nwg % NXCD, xcd = wgid % NXCD, off = wgid / NXCD; wgid = (xcd < r ? xcd * (q + 1) : r * (q + 1) + (xcd - r) * q) + off; }
        const int nig = WGM * nN, gid = wgid / nig, fm = gid * WGM, gsz = (nM - fm) < WGM ? (nM - fm) : WGM;
        u.pm = fm + ((wgid % nig) % gsz); u.pn = (wgid % nig) / gsz; u.aux = s;
        u.A = (s ? A1 : A0) + (size_t)u.pm * atile; u.B = (s ? B1 : B0) + (size_t)u.pn * btile; return true;
    }
};

#ifndef GEMM_SP2
#define GEMM_SP2 1
#endif
#ifndef GEMM_ALIGN
#define GEMM_ALIGN 1
#endif
#if !NAIVE_GEMM
template <class Epi, bool ALIGN_EPI = (GEMM_ALIGN != 0), bool SP2 = (GEMM_SP2 != 0)>
__device__ __forceinline__ void gemm_phase(LAS unsigned char* lds, const int K, const int lda, const int ldb, const Sched& S, const Epi& E) {
    int tid_ = threadIdx.x; asm volatile("" : "+v"(tid_));
    const int tid = tid_, wid = __builtin_amdgcn_readfirstlane(tid >> 6), lane = tid & 63, wr = wid >> 2, wc = wid & 3, fr = lane & 15, fq = lane >> 4;
    const int nt = K / BK;
    unsigned voffA[2], voffB[2];
#pragma unroll
    for (int i = 0; i < 2; ++i) { int R, C; stage_rc(tid * 16 + i * 8192, R, C); const int Rb = (R & ~31) + perm32(R & 31);
        voffA[i] = (unsigned)(R * lda + C) * 2u; voffB[i] = (unsigned)(Rb * ldb + C) * 2u; }
    const size_t kstep = (size_t)(BK * 2);
    const size_t hstepA = (size_t)HALF * lda * 2, hstepB = (size_t)HALF * ldb * 2;
    const unsigned ldsw = (unsigned)wid * 1024u;
    const int aoff = lds_byte(wr * 64 + fr, fq * 8), boff = lds_byte(wc * 32 + fr, fq * 8);
#define PG8_SA(b, h) (((b) * 2 + (h)) * HTB)
#define PG8_SB(b, h) ((4 + (b) * 2 + (h)) * HTB)
#define PG8_STAGE(bufoff, gbase, voff) do { _Pragma("unroll") for (int _i = 0; _i < 2; ++_i) \
        __builtin_amdgcn_global_load_lds((const unsigned*)((const char*)(gbase) + (voff)[_i]), (LAS unsigned*)(lds + (bufoff) + ldsw + _i * 8192), 16, 0, 0); } while (0)
#define PG8_LDA(dst, b, h) do { _Pragma("unroll") for (int m = 0; m < 4; ++m) _Pragma("unroll") for (int k = 0; k < 2; ++k) dst[m][k] = *(const LAS bf16x8*)(lds + PG8_SA(b, h) + aoff + m * 2048 + k * 1024); } while (0)
#define PG8_LDB(dst, b, h) do { _Pragma("unroll") for (int n = 0; n < 2; ++n) _Pragma("unroll") for (int k = 0; k < 2; ++k) dst[n][k] = *(const LAS bf16x8*)(lds + PG8_SB(b, h) + boff + n * 2048 + k * 1024); } while (0)
#define PG8_MMA(ai, bj, At, Bt) do { __builtin_amdgcn_s_setprio(1); _Pragma("unroll") for (int m = 0; m < 4; ++m) _Pragma("unroll") for (int n = 0; n < 2; ++n) _Pragma("unroll") for (int k = 0; k < 2; ++k) \
        acc[ai][bj][m][n] = __builtin_amdgcn_mfma_f32_16x16x32_bf16(Bt[n][k], At[m][k], acc[ai][bj][m][n], 0, 0, 0); __builtin_amdgcn_s_setprio(0); } while (0)
#define PG8_WAIT_V(n) asm volatile("s_waitcnt vmcnt(" #n ")" ::: "memory")
#define PG8_WAIT_L(n) asm volatile("s_waitcnt lgkmcnt(" #n ")" ::: "memory")
#define PG8_BAR __builtin_amdgcn_s_barrier()
#define PG8_SCHED __builtin_amdgcn_sched_barrier(0)
    Unit cur, nxt; int ui = 0;
    if (!S.next(0, cur)) return;
    f32x4 acc[2][2][4][2];
#pragma unroll
    for (int a = 0; a < 2; ++a)
#pragma unroll
        for (int b = 0; b < 2; ++b)
#pragma unroll
            for (int m = 0; m < 4; ++m)
#pragma unroll
                for (int n = 0; n < 2; ++n) acc[a][b][m][n] = (f32x4){0.f, 0.f, 0.f, 0.f};
    bf16x8 At[4][2], B0[2][2], B1[2][2];
    const char* cA = cur.A; const char* cB = cur.B;
    if constexpr (SP2) {
        PG8_STAGE(PG8_SB(0, 0), cB, voffB); PG8_STAGE(PG8_SB(0, 1), cB + hstepB, voffB); PG8_STAGE(PG8_SA(0, 0), cA, voffA); PG8_STAGE(PG8_SA(0, 1), cA + hstepA, voffA);
        if (wr == 1) PG8_BAR;
        PG8_WAIT_V(2); PG8_BAR;
        PG8_STAGE(PG8_SB(1, 0), cB + kstep, voffB); PG8_STAGE(PG8_SA(1, 0), cA + kstep, voffA); PG8_STAGE(PG8_SB(1, 1), cB + hstepB + kstep, voffB);
        PG8_WAIT_V(6); PG8_BAR;
    } else {
        PG8_STAGE(PG8_SB(0, 0), cB, voffB); PG8_STAGE(PG8_SA(0, 0), cA, voffA); PG8_STAGE(PG8_SB(0, 1), cB + hstepB, voffB); PG8_STAGE(PG8_SA(0, 1), cA + hstepA, voffA);
        if (wr == 1) PG8_BAR;
        PG8_WAIT_V(4); PG8_BAR;
        PG8_STAGE(PG8_SB(1, 0), cB + kstep, voffB); PG8_STAGE(PG8_SA(1, 0), cA + kstep, voffA); PG8_STAGE(PG8_SB(1, 1), cB + hstepB + kstep, voffB);
        PG8_WAIT_V(6); PG8_BAR;
    }
    for (;;) {
        const bool has_next = S.next(ui + 1, nxt);
        const char* nA = has_next ? nxt.A : cA; const char* nB = has_next ? nxt.B : cB;
        for (int t = 0; t < nt; t += 2) {
            const bool last = (t == nt - 2);
            const char* a1 = cA + (size_t)(t + 1) * kstep;
            const char* a2 = last ? nA : cA + (size_t)(t + 2) * kstep; const char* b2 = last ? nB : cB + (size_t)(t + 2) * kstep;
            const char* a3 = a2 + kstep; const char* b3 = b2 + kstep;
            if constexpr (SP2) {
            PG8_LDB(B0, 0, 0); PG8_LDB(B1, 0, 1); PG8_SCHED; PG8_LDA(At, 0, 0); PG8_STAGE(PG8_SA(1, 1), a1 + hstepA, voffA);
            PG8_WAIT_V(8); PG8_WAIT_L(0); PG8_BAR; PG8_MMA(0, 0, At, B0); PG8_MMA(0, 1, At, B1); PG8_BAR; PG8_SCHED;
            PG8_LDA(At, 0, 1); PG8_STAGE(PG8_SB(0, 0), b2, voffB); PG8_STAGE(PG8_SB(0, 1), b2 + hstepB, voffB); PG8_STAGE(PG8_SA(0, 0), a2, voffA);
            PG8_WAIT_V(8); PG8_WAIT_L(0); PG8_BAR; PG8_MMA(1, 0, At, B0); PG8_MMA(1, 1, At, B1); PG8_BAR; PG8_SCHED;
            PG8_LDB(B0, 1, 0); PG8_LDB(B1, 1, 1); PG8_SCHED; PG8_LDA(At, 1, 0); PG8_STAGE(PG8_SA(0, 1), a2 + hstepA, voffA);
            PG8_WAIT_V(8); PG8_WAIT_L(0); PG8_BAR; PG8_MMA(0, 0, At, B0); PG8_MMA(0, 1, At, B1); PG8_BAR; PG8_SCHED;
            PG8_LDA(At, 1, 1); PG8_STAGE(PG8_SB(1, 0), b3, voffB); PG8_STAGE(PG8_SB(1, 1), b3 + hstepB, voffB); PG8_STAGE(PG8_SA(1, 0), a3, voffA);
            PG8_WAIT_V(8); PG8_WAIT_L(0); PG8_BAR; PG8_MMA(1, 0, At, B0); PG8_MMA(1, 1, At, B1); PG8_BAR; PG8_SCHED;
            } else {
            PG8_LDB(B0, 0, 0); PG8_SCHED; PG8_LDA(At, 0, 0); PG8_STAGE(PG8_SA(1, 1), a1 + hstepA, voffA);
            PG8_WAIT_L(8); PG8_BAR; PG8_WAIT_L(0); PG8_MMA(0, 0, At, B0); PG8_BAR; PG8_SCHED;
            PG8_LDB(B1, 0, 1); PG8_STAGE(PG8_SB(0, 0), b2, voffB);
            PG8_BAR; PG8_WAIT_L(0); PG8_MMA(0, 1, At, B1); PG8_BAR;
            PG8_LDA(At, 0, 1); PG8_STAGE(PG8_SA(0, 0), a2, voffA);
            PG8_BAR; PG8_WAIT_L(0); PG8_MMA(1, 0, At, B0); PG8_BAR; PG8_SCHED;
            PG8_STAGE(PG8_SB(0, 1), b2 + hstepB, voffB);
            PG8_WAIT_V(6); PG8_BAR; PG8_MMA(1, 1, At, B1); PG8_BAR;
            PG8_LDB(B0, 1, 0); PG8_SCHED; PG8_LDA(At, 1, 0); PG8_STAGE(PG8_SA(0, 1), a2 + hstepA, voffA);
            PG8_WAIT_L(8); PG8_BAR; PG8_WAIT_L(0); PG8_MMA(0, 0, At, B0); PG8_BAR; PG8_SCHED;
            PG8_LDB(B1, 1, 1); PG8_STAGE(PG8_SB(1, 0), b3, voffB);
            PG8_BAR; PG8_WAIT_L(0); PG8_MMA(0, 1, At, B1); PG8_BAR;
            PG8_LDA(At, 1, 1); PG8_STAGE(PG8_SA(1, 0), a3, voffA);
            PG8_BAR; PG8_WAIT_L(0); PG8_MMA(1, 0, At, B0); PG8_BAR; PG8_SCHED;
            PG8_STAGE(PG8_SB(1, 1), b3 + hstepB, voffB);
            PG8_WAIT_V(6); PG8_BAR; PG8_MMA(1, 1, At, B1); PG8_BAR;
            }
        }
        if constexpr (ALIGN_EPI) { if (wr == 0) PG8_BAR; }
        E(acc, cur, wr, wc, fr, fq);
        if (!has_next) break;
        if (!(Epi::KEEP_ACC && cur.aux == 0)) {
#pragma unroll
        for (int a = 0; a < 2; ++a)
#pragma unroll
            for (int b = 0; b < 2; ++b)
#pragma unroll
                for (int m = 0; m < 4; ++m)
#pragma unroll
                    for (int n = 0; n < 2; ++n) acc[a][b][m][n] = (f32x4){0.f, 0.f, 0.f, 0.f};
        }
        cur = nxt; cA = nA; cB = nB; ++ui;
        if constexpr (ALIGN_EPI) { if (wr == 1) PG8_BAR; }
    }
    PG8_WAIT_V(0);
    if constexpr (!ALIGN_EPI) { if (wr == 0) PG8_BAR; }
    PG8_BAR;
#undef PG8_SA
#undef PG8_SB
#undef PG8_STAGE
#undef PG8_LDA
#undef PG8_LDB
#undef PG8_MMA
#undef PG8_WAIT_V
#undef PG8_WAIT_L
#undef PG8_BAR
#undef PG8_SCHED
}
#else
template <class Epi, bool ALIGN_EPI = false, bool SP2 = false>
__device__ __forceinline__ void gemm_phase(LAS unsigned char* lds, const int K, const int lda, const int ldb, const Sched& S, const Epi& E) {
    const int tid = opaque_tid(), wid = tid >> 6, lane = tid & 63, wr = wid >> 2, wc = wid & 3, fr = lane & 15, fq = lane >> 4;
    Unit cur;
    f32x4 acc[2][2][4][2];
    for (int ui = 0; S.next(ui, cur); ++ui) {
        if (!(Epi::KEEP_ACC && cur.aux == 1))
#pragma unroll
        for (int a = 0; a < 2; ++a)
#pragma unroll
            for (int b = 0; b < 2; ++b)
#pragma unroll
                for (int m = 0; m < 4; ++m)
#pragma unroll
                    for (int n = 0; n < 2; ++n) acc[a][b][m][n] = (f32x4){0.f, 0.f, 0.f, 0.f};
        for (int kb = 0; kb < K; kb += 32) {
#pragma unroll
            for (int ai = 0; ai < 2; ++ai)
#pragma unroll
                for (int bj = 0; bj < 2; ++bj) {
                    bf16x8 bf[2];
#pragma unroll
                    for (int n = 0; n < 2; ++n) bf[n] = *(const bf16x8*)(cur.B + ((size_t)(bj * 128 + wc * 32 + perm32(16 * n + fr)) * ldb + kb + fq * 8) * 2);
#pragma unroll
                    for (int m = 0; m < 4; ++m) {
                        const bf16x8 af = *(const bf16x8*)(cur.A + ((size_t)(ai * 128 + wr * 64 + m * 16 + fr) * lda + kb + fq * 8) * 2);
#pragma unroll
                        for (int n = 0; n < 2; ++n) acc[ai][bj][m][n] = __builtin_amdgcn_mfma_f32_16x16x32_bf16(bf[n], af, acc[ai][bj][m][n], 0, 0, 0);
                    }
                }
        }
        E(acc, cur, wr, wc, fr, fq);
    }
}
#endif
}
using pg8::Unit;

struct EpiG1 {
    static constexpr bool KEEP_ACC = false;
    bf16_t* prec; bf16_t* pm_;
    __device__ __forceinline__ void operator()(const f32x4 (&acc)[2][2][4][2], const Unit& u, int wr, int wc, int fr, int fq) const {
        const int pn = u.pn;
        const int act = pn < 4 ? 1 : (pn >= 28 ? 2 : ((pn == 16 || pn == 17) ? 3 : 0));
        bf16_t* base; int ld, c0;
        if (pn < 28) { base = prec; ld = PREC_W; c0 = pn * 256; } else { base = pm_; ld = PM_W; c0 = (pn - 28) * 256; }
#pragma unroll
        for (int ai = 0; ai < 2; ++ai)
#pragma unroll
            for (int m = 0; m < 4; ++m) {
                const int row = u.pm * 256 + ai * 128 + wr * 64 + m * 16 + fr;
                bf16_t* rp = base + (size_t)row * ld + c0 + wc * 32 + 8 * fq;
#pragma unroll
                for (int bj = 0; bj < 2; ++bj) {
                    f32x4 v0 = acc[ai][bj][m][0], v1 = acc[ai][bj][m][1];
                    if (act == 1) {
#pragma unroll
                        for (int j = 0; j < 4; ++j) { v0[j] = siluf_(v0[j]); v1[j] = siluf_(v1[j]); }
                    } else if (act == 2) {
#pragma unroll
                        for (int j = 0; j < 4; ++j) { v0[j] = sigmoidf_(v0[j]); v1[j] = sigmoidf_(v1[j]); }
                    } else if (act == 3) { v0 = v0 * 0.08838834764831845f; v1 = v1 * 0.08838834764831845f; }
                    __builtin_nontemporal_store((u32x4){pk2(v0[0], v0[1]), pk2(v0[2], v0[3]), pk2(v1[0], v1[1]), pk2(v1[2], v1[3])}, (u32x4*)(rp + bj * 128));
                }
            }
    }
};
struct EpiG2 {
    static constexpr bool KEEP_ACC = true;
    bf16_t* merged; const bf16_t* pm_;
    __device__ __forceinline__ void operator()(f32x4 (&acc)[2][2][4][2], const Unit& u, int wr, int wc, int fr, int fq) const {
        const int s = u.aux;
#pragma unroll
        for (int ai = 0; ai < 2; ++ai)
#pragma unroll
            for (int m = 0; m < 4; ++m) {
                const int row = u.pm * 256 + ai * 128 + wr * 64 + m * 16 + fr;
#pragma unroll
                for (int bj = 0; bj < 2; ++bj) {
                    const int c = u.pn * 256 + bj * 128 + wc * 32 + 8 * fq;
                    const u32x4 gb = *(const u32x4*)(pm_ + (size_t)row * PM_W + 2048 + c);
                    if (s == 0) {
                        const u32x4 ga = *(const u32x4*)(pm_ + (size_t)row * PM_W + c);
#pragma unroll
                        for (int q = 0; q < 2; ++q) {
                            acc[ai][bj][m][0][2 * q] *= bflo(ga[q]) * __builtin_amdgcn_rcpf(bflo(gb[q])); acc[ai][bj][m][0][2 * q + 1] *= bfhi(ga[q]) * __builtin_amdgcn_rcpf(bfhi(gb[q]));
                            acc[ai][bj][m][1][2 * q] *= bflo(ga[2 + q]) * __builtin_amdgcn_rcpf(bflo(gb[2 + q])); acc[ai][bj][m][1][2 * q + 1] *= bfhi(ga[2 + q]) * __builtin_amdgcn_rcpf(bfhi(gb[2 + q]));
                        }
                    } else {
                        const f32x4 a0 = acc[ai][bj][m][0], a1 = acc[ai][bj][m][1];
                        float v[8];
                        v[0] = a0[0] * bflo(gb[0]); v[1] = a0[1] * bfhi(gb[0]); v[2] = a0[2] * bflo(gb[1]); v[3] = a0[3] * bfhi(gb[1]);
                        v[4] = a1[0] * bflo(gb[2]); v[5] = a1[1] * bfhi(gb[2]); v[6] = a1[2] * bflo(gb[3]); v[7] = a1[3] * bfhi(gb[3]);
                        *(u32x4*)(merged + (size_t)row * DM + c) = (u32x4){pk2(v[0], v[1]), pk2(v[2], v[3]), pk2(v[4], v[5]), pk2(v[6], v[7])};
                    }
                }
            }
    }
};
template <bool IN_BF16> struct EpiResT {
    static constexpr bool KEEP_ACC = false;
    const void* xin; bf16_t* xout; const float* gt; int ldi, ldo;
    __device__ __forceinline__ void operator()(const f32x4 (&acc)[2][2][4][2], const Unit& u, int wr, int wc, int fr, int fq) const {
        const int b = (u.pm * 256) >> 11;
#pragma unroll
        for (int bj = 0; bj < 2; ++bj) {
            const int c = u.pn * 256 + bj * 128 + wc * 32 + 8 * fq;
            const f32x4 g0 = *(const f32x4*)(gt + (size_t)b * NMOD + c), g1 = *(const f32x4*)(gt + (size_t)b * NMOD + c + 4);
#pragma unroll
            for (int ai = 0; ai < 2; ++ai)
#pragma unroll
                for (int m = 0; m < 4; ++m) {
                    const int row = u.pm * 256 + ai * 128 + wr * 64 + m * 16 + fr;
                    f32x4 x0, x1;
                    if (IN_BF16) { const u32x4 xv = *(const u32x4*)((const bf16_t*)xin + (size_t)row * ldi + c);
                        x0 = (f32x4){bflo(xv[0]), bfhi(xv[0]), bflo(xv[1]), bfhi(xv[1])}; x1 = (f32x4){bflo(xv[2]), bfhi(xv[2]), bflo(xv[3]), bfhi(xv[3])}; }
                    else { const float* ip = (const float*)xin + (size_t)row * ldi + c; x0 = *(const f32x4*)ip; x1 = *(const f32x4*)(ip + 4); }
                    const f32x4 r0 = x0 + g0 * acc[ai][bj][m][0], r1 = x1 + g1 * acc[ai][bj][m][1];
                    *(u32x4*)(xout + (size_t)row * ldo + c) = (u32x4){pk2(r0[0], r0[1]), pk2(r0[2], r0[3]), pk2(r1[0], r1[1]), pk2(r1[2], r1[3])};
                }
        }
    }
};
struct EpiG4 {
    static constexpr bool KEEP_ACC = false;
    bf16_t* actb;
    __device__ __forceinline__ void operator()(const f32x4 (&acc)[2][2][4][2], const Unit& u, int wr, int wc, int fr, int fq) const {
#pragma unroll
        for (int ai = 0; ai < 2; ++ai)
#pragma unroll
            for (int m = 0; m < 4; ++m) {
                const int row = u.pm * 256 + ai * 128 + wr * 64 + m * 16 + fr;
                const f32x4 g0 = acc[ai][0][m][0], g1 = acc[ai][0][m][1], u0 = acc[ai][1][m][0], u1 = acc[ai][1][m][1];
                float v[8];
#pragma unroll
                for (int j = 0; j < 4; ++j) { v[j] = siluf_(g0[j]) * u0[j]; v[4 + j] = siluf_(g1[j]) * u1[j]; }
                *(u32x4*)(actb + (size_t)row * FFH + u.pn * 128 + wc * 32 + 8 * fq) = (u32x4){pk2(v[0], v[1]), pk2(v[2], v[3]), pk2(v[4], v[5]), pk2(v[6], v[7])};
            }
    }
};

__device__ __forceinline__ void tr_tile(const float* __restrict__ src, const int ldsrc, const int c_lo, const int c_hi, const int k0, bf16_t* __restrict__ dst, const int K, const int n0, unsigned char* lds) {
    bf16_t* T = (bf16_t*)lds;
    const int tid = opaque_tid();
    f32x4 v[8];
#pragma unroll
    for (int i = 0; i < 8; ++i) {
        const int idx = tid + 512 * i, r = idx >> 6, c4 = idx & 63;
        v[i] = *(const f32x4*)(src + (size_t)(k0 + r) * ldsrc + (c4 < 32 ? c_lo + 4 * c4 : c_hi + 4 * (c4 - 32)));
    }
#pragma unroll
    for (int i = 0; i < 8; ++i) {
        const int idx = tid + 512 * i, r = idx >> 6, c4 = idx & 63;
        const unsigned p01 = pk2(v[i][0], v[i][1]), p23 = pk2(v[i][2], v[i][3]);
        T[(4 * c4 + 0) * 72 + r] = (bf16_t)(p01 & 0xffffu); T[(4 * c4 + 1) * 72 + r] = (bf16_t)(p01 >> 16);
        T[(4 * c4 + 2) * 72 + r] = (bf16_t)(p23 & 0xffffu); T[(4 * c4 + 3) * 72 + r] = (bf16_t)(p23 >> 16);
    }
    __syncthreads();
#pragma unroll
    for (int i = 0; i < 4; ++i) {
        const int idx = tid + 512 * i, n = idx >> 3, k8 = idx & 7;
        __builtin_nontemporal_store(*(const u32x4*)(T + n * 72 + 8 * k8), (u32x4*)(dst + (size_t)(n0 + n) * K + k0 + 8 * k8));
    }
    __syncthreads();
}

struct TrTile { const float* sp; size_t ldsrc; bf16_t* dst; int K; };
__device__ __forceinline__ TrTile tr_make(const float* src, int ldsrc, int c_lo, int c_hi, int k0, bf16_t* dst, int K, int n0, int tid) {
    const int n = tid & 255, kh = tid >> 8;
    TrTile t; t.sp = src + (size_t)(k0 + 32 * kh) * ldsrc + (n < 128 ? c_lo + n : c_hi + n - 128); t.ldsrc = (size_t)ldsrc; t.dst = dst + (size_t)n0 * K + k0; t.K = K; return t;
}
constexpr int LT_UP = 16 * 8, LT_O = 32 * 8, LT_FFI = 32 * 44, LT_FFO = 88 * 8, LT_TOTAL = 2 * LT_UP + LT_O + LT_FFI + LT_FFO;
__device__ __forceinline__ TrTile later_tile(const Params& p, int r, int tid) {
    if (r < LT_UP) { const int kt = r / 8, nt = r % 8; return tr_make(p.w_up_a, 2048, nt * 256, nt * 256 + 128, kt * 64, (bf16_t*)(p.ws + OFF_WT_UPA), 1024, nt * 256, tid); } r -= LT_UP;
    if (r < LT_UP) { const int kt = r / 8, nt = r % 8; return tr_make(p.w_up_b, 2048, nt * 256, nt * 256 + 128, kt * 64, (bf16_t*)(p.ws + OFF_WT_UPB), 1024, nt * 256, tid); } r -= LT_UP;
    if (r < LT_O) { const int kt = r / 8, nt = r % 8; return tr_make(p.w_o, 2048, nt * 256, nt * 256 + 128, kt * 64, (bf16_t*)(p.ws + OFF_WT_O), 2048, nt * 256, tid); } r -= LT_O;
    if (r < LT_FFI) { const int kt = r / 44, nt = r % 44; return tr_make(p.w_ffn_in, 2 * FFH, 128 * nt, FFH + 128 * nt, kt * 64, (bf16_t*)(p.ws + OFF_WT_FFI), 2048, nt * 256, tid); } r -= LT_FFI;
    { const int kt = r / 8, nt = r % 8; return tr_make(p.w_ffn_out, 2048, nt * 256, nt * 256 + 128, kt * 64, (bf16_t*)(p.ws + OFF_WT_FFO), FFH, nt * 256, tid); }
}
__device__ __forceinline__ void tr_load(const TrTile& t, float (&v)[32]) {
#pragma unroll
    for (int i = 0; i < 32; ++i) v[i] = t.sp[(size_t)i * t.ldsrc];
}
__device__ __forceinline__ void tr_to_lds(bf16_t* T, const float (&v)[32], int tid) {
    const int n = tid & 255, kh = tid >> 8;
#pragma unroll
    for (int q = 0; q < 8; ++q) *(u32x2*)(T + n * 68 + 32 * kh + 4 * q) = (u32x2){pk2(v[4 * q], v[4 * q + 1]), pk2(v[4 * q + 2], v[4 * q + 3])};
}
__device__ __forceinline__ void tr_store(const bf16_t* T, const TrTile& t, int tid) {
#pragma unroll
    for (int i = 0; i < 4; ++i) {
        const int idx = tid + 512 * i, nn = idx >> 3, k8 = idx & 7;
        const u32x2 lo = *(const u32x2*)(T + nn * 68 + 8 * k8), hi = *(const u32x2*)(T + nn * 68 + 8 * k8 + 4);
        __builtin_nontemporal_store((u32x4){lo[0], lo[1], hi[0], hi[1]}, (u32x4*)(t.dst + (size_t)nn * t.K + 8 * k8));
    }
}
__device__ __forceinline__ void mod_job(const Params& p, const int job, unsigned char* lds) {
    float* sc = (float*)lds;
    float* red = (float*)(lds + 65536);
    const int tid = opaque_tid(), lane = tid & 63, wave = tid >> 6;
    for (int i = tid; i < 8 * 2048; i += 512) sc[i] = siluf_(p.c[i]);
    __syncthreads();
    const int cg4 = lane & 15, ks = wave * 4 + (lane >> 4);
    const int col = job * 64 + cg4 * 4;
    f32x4 acc[8];
#pragma unroll
    for (int b = 0; b < 8; ++b) acc[b] = (f32x4){0.f, 0.f, 0.f, 0.f};
    const float* wp = p.w_ada + (size_t)(ks * 64) * NMOD + col;
#pragma unroll 8
    for (int kk = 0; kk < 64; ++kk) {
        const f32x4 w = *(const f32x4*)(wp + (size_t)kk * NMOD);
        const int k = ks * 64 + kk;
#pragma unroll
        for (int b = 0; b < 8; ++b) acc[b] += w * sc[b * 2048 + k];
    }
#pragma unroll
    for (int b = 0; b < 8; ++b)
#pragma unroll
        for (int j = 0; j < 4; ++j) { float v = acc[b][j]; v += __shfl_xor(v, 16); v += __shfl_xor(v, 32); if (lane < 16) red[(wave * 8 + b) * 64 + cg4 * 4 + j] = v; }
    __syncthreads();
    { const int b = tid >> 6, cc = tid & 63; float s = 0.f;
#pragma unroll
      for (int w = 0; w < 8; ++w) s += red[(w * 8 + b) * 64 + cc];
      ((float*)(p.ws + OFF_MOD))[b * NMOD + job * 64 + cc] = s + p.b_ada[job * 64 + cc]; }
    __syncthreads();
}
__device__ __forceinline__ void phase_prep(const Params& p, unsigned char* lds) {
    constexpr int NMODJ = 192, T_IN = 32 * 44, NJOBS = NMODJ + T_IN;
    {   u32x4* g = (u32x4*)(p.ws + OFF_GRAN);
        for (size_t i = (size_t)blockIdx.x * 512 + threadIdx.x; i < GRAN_BYTES / 16; i += (size_t)gridDim.x * 512) g[i] = (u32x4){0u, 0u, 0u, 0u}; }
    for (int j = blockIdx.x; j < NJOBS; j += gridDim.x) {
        int r = j;
        if (r < NMODJ) { mod_job(p, r, lds); continue; } r -= NMODJ;
        { const int kt = r / 44, nt = r % 44, n0 = nt * 256, c0 = n0 < 7168 ? n0 : n0 + 16; tr_tile(p.w_in, INW, c0, c0 + 128, kt * 64, (bf16_t*)(p.ws + OFF_WT_IN), 2048, n0, lds); }
    }
}

__device__ __forceinline__ void phase_h(const Params& p, unsigned char* lds) {
    bf16_t* wg = (bf16_t*)lds;
    const int tid = opaque_tid(), lane = tid & 63, wave = tid >> 6;
    for (int i = tid; i < 8192; i += 512) { const int k = i >> 2, q = i & 3; const f32x4 v = *(const f32x4*)(p.w_in + (size_t)k * INW + 7168 + 4 * q);
        const unsigned p01 = pk2(v[0], v[1]), p23 = pk2(v[2], v[3]);
        wg[(4 * q + 0) * 2048 + k] = (bf16_t)(p01 & 0xffffu); wg[(4 * q + 1) * 2048 + k] = (bf16_t)(p01 >> 16); wg[(4 * q + 2) * 2048 + k] = (bf16_t)(p23 & 0xffffu); wg[(4 * q + 3) * 2048 + k] = (bf16_t)(p23 >> 16); }
    float* wk2 = (float*)(lds + 65536);
    for (int i = tid; i < 2048; i += 512) *(f32x4*)(wk2 + 4 * i) = *(const f32x4*)(p.w_gk2 + 4 * i);
    __syncthreads();
    const f32x4 bk0 = *(const f32x4*)(p.b_gk2 + 8 * lane), bk1 = *(const f32x4*)(p.b_gk2 + 8 * lane + 4);
    const float* MOD = (const float*)(p.ws + OFF_MOD); bf16_t* H = (bf16_t*)p.out; bf16_t* GDEC = (bf16_t*)(p.ws + OFF_GDEC);
    const int rstep = gridDim.x * 8;
    for (int row = blockIdx.x * 8 + wave; row < NTOK; row += rstep) {
        const int b = row >> 11;
        f32x4 xv[8];
#pragma unroll
        for (int i = 0; i < 8; ++i) xv[i] = *(const f32x4*)(p.x + (size_t)row * DM + i * 256 + lane * 4);
        const int rnext = row + rstep < NTOK ? row + rstep : row;
        const float pf = p.x[(size_t)rnext * DM + lane * 32];
        float ss = 0.f;
#pragma unroll
        for (int i = 0; i < 8; ++i) ss += xv[i][0] * xv[i][0] + xv[i][1] * xv[i][1] + xv[i][2] * xv[i][2] + xv[i][3] * xv[i][3];
        ss = wave_sum(ss);
        const float rstd = rsqrtf(ss * (1.f / 2048.f) + EPS);
        float part[16];
#pragma unroll
        for (int n = 0; n < 16; ++n) part[n] = 0.f;
#pragma unroll
        for (int i = 0; i < 8; ++i) {
            const int col = i * 256 + lane * 4;
            const f32x4 w = *(const f32x4*)(p.norm1_w + col), sc = *(const f32x4*)(MOD + (size_t)b * NMOD + 2048 + col), sh = *(const f32x4*)(MOD + (size_t)b * NMOD + col);
            f32x4 hv;
#pragma unroll
            for (int j = 0; j < 4; ++j) hv[j] = xv[i][j] * rstd * w[j] * (1.f + sc[j]) + sh[j];
            __builtin_nontemporal_store((u32x2){pk2(hv[0], hv[1]), pk2(hv[2], hv[3])}, (u32x2*)(H + (size_t)row * DM + col));
#pragma unroll
            for (int n = 0; n < 16; ++n) {
                const u32x2 w4 = *(const u32x2*)(wg + n * 2048 + col);
                part[n] += hv[0] * bflo(w4[0]) + hv[1] * bfhi(w4[0]) + hv[2] * bflo(w4[1]) + hv[3] * bfhi(w4[1]);
            }
            __builtin_amdgcn_sched_barrier(0);
        }
#pragma unroll
        for (int n = 0; n < 16; ++n) part[n] = wave_sum(part[n]);
        {
            f32x4 z0 = bk0, z1 = bk1;
#pragma unroll
            for (int r = 0; r < 16; ++r) { const f32x4 wa = *(const f32x4*)(wk2 + r * 512 + 8 * lane), wb = *(const f32x4*)(wk2 + r * 512 + 8 * lane + 4); z0 += wa * part[r]; z1 += wb * part[r]; }
            float g[8];
#pragma unroll
            for (int j = 0; j < 4; ++j) { g[j] = -0.0625f * 0.6931471805599453f * __log2f(1.f + __expf(-z0[j])); g[4 + j] = -0.0625f * 0.6931471805599453f * __log2f(1.f + __expf(-z1[j])); }
            *(u32x4*)(GDEC + (size_t)row * 512 + 8 * lane) = (u32x4){pk2(g[0], g[1]), pk2(g[2], g[3]), pk2(g[4], g[5]), pk2(g[6], g[7])};
        }
        asm volatile("" :: "v"(pf));
    }
}

constexpr int RP = 136;
constexpr int VP = 72;
constexpr int OBP = 68;
__device__ __forceinline__ bf16x8 mk8(unsigned a, unsigned b, unsigned c, unsigned d) { return __builtin_bit_cast(bf16x8, (u32x4){a, b, c, d}); }

template <bool IS_A>
__device__ __forceinline__ void rec_finish(unsigned long long* GR, unsigned long long (&sg)[4], const int sib0, const int item, const int chunk, const int vj, const float ss_own,
                                           const f32x4 o0, const f32x4 o1, const f32x4 nw0, const f32x4 nw1, const u32x4 gate, bf16_t* dstp) {
    float total = ss_own;
#pragma unroll
    for (int k = 0; k < (IS_A ? 2 : 4); ++k) {
        if (sib0 + k == item) continue;
        unsigned long long x = sg[k];
        for (unsigned spins = 0; (unsigned)(x >> 32) != (unsigned)(chunk + 1) && spins < (1u << 22); ++spins) { __builtin_amdgcn_s_sleep(1); x = __hip_atomic_load(GR + ((size_t)(sib0 + k) * 32 + chunk) * 64 + vj, __ATOMIC_RELAXED, __HIP_MEMORY_SCOPE_AGENT); }
        total += __uint_as_float((unsigned)x);
    }
    const float rs = rsqrtf(total * (IS_A ? (1.f / 128.f) : (1.f / 256.f)) + EPS);
    const float g[8] = {bflo(gate[0]), bfhi(gate[0]), bflo(gate[1]), bfhi(gate[1]), bflo(gate[2]), bfhi(gate[2]), bflo(gate[3]), bfhi(gate[3])};
    float y[8];
#pragma unroll
    for (int j = 0; j < 4; ++j) { y[j] = o0[j] * rs * nw0[j] * siluf_(g[j]); y[4 + j] = o1[j] * rs * nw1[j] * siluf_(g[4 + j]); }
    __builtin_nontemporal_store((u32x4){pk2(y[0], y[1]), pk2(y[2], y[3]), pk2(y[4], y[5]), pk2(y[6], y[7])}, (u32x4*)dstp);
}
template <bool IS_A>
__device__ __forceinline__ void rec_item2(const Params& p, unsigned char* lds, const int item, const int b, const int h, const int es, const bool side_on, const int side_first, const int side_stride) {
    bf16_t* QL = (bf16_t*)lds; bf16_t* KD = QL + 64 * RP; bf16_t* KE = KD + 64 * RP; bf16_t* QI = KE + 64 * RP; bf16_t* XB = QI + 64 * RP;
    bf16_t* KDT = XB + 48 * RP;
    bf16_t* VT = KDT + 128 * VP;
    bf16_t* AT = VT + 64 * VP;
    float* T8 = (float*)(AT + 64 * VP);
    float* EB = T8 + 1024;
    float* GKl = EB + 128;
    float* OB = (float*)lds;
    bf16_t* TT = (bf16_t*)(lds + 128256);
    const int tid = opaque_tid(), lane = tid & 63, wave = __builtin_amdgcn_readfirstlane(tid >> 6), fr = lane & 15, fq = lane >> 4, dh = wave >> 2, eb = wave & 3;
    const bf16_t* PREC = (const bf16_t*)(p.ws + OFF_PREC);
    const bf16_t* GDEC = (const bf16_t*)(p.ws + OFF_GDEC);
    bf16_t* Y = (bf16_t*)p.out;
    unsigned long long* GR = (unsigned long long*)(p.ws + OFF_GRAN);
    const int sib0 = IS_A ? (item & ~1) : 128 + ((item - 128) & ~3);
    const int gcol = IS_A ? 3072 + h * 128 + es * 64 : 6144 + h * 256 + es * 64;
    const int qcol = IS_A ? h * 128 : 4096 + h * 128;
    const int kcol = IS_A ? 1024 + h * 128 : 4608 + h * 128;
    const int vcol = IS_A ? 2048 + h * 128 + es * 64 : 5120 + h * 256 + es * 64;
    const int ocol = IS_A ? h * 128 + es * 64 : 1024 + h * 256 + es * 64;
    const int d0 = 2 * lane, r0 = 8 * wave, sub = wave >> 1;
    const int vj = tid >> 3, ve8 = (tid & 7) * 8;
    const f32x4 nw0 = *(const f32x4*)((IS_A ? p.a_norm_w : p.b_norm_w) + es * 64 + ve8), nw1 = *(const f32x4*)((IS_A ? p.a_norm_w : p.b_norm_w) + es * 64 + ve8 + 4);
    const size_t row0 = (size_t)b * 2048;
    float lb0 = 0.f, lb1 = 0.f;
    if (IS_A) { const int ch = h * 128 + d0; lb0 = 1.f / (1.f + __expf(p.lb_param[1024 + ch] - p.lb_param[ch])); lb1 = 1.f / (1.f + __expf(p.lb_param[1025 + ch] - p.lb_param[ch + 1])); }
    f32x4 S[4];
#pragma unroll
    for (int i = 0; i < 4; ++i) S[i] = (f32x4){0.f, 0.f, 0.f, 0.f};
    for (int i = tid; i < 64 * VP / 2; i += 512) ((unsigned*)AT)[i] = 0u;
    unsigned qraw[8], kraw[8], graw[8]; u32x4 vraw;
#pragma unroll
    for (int r = 0; r < 8; ++r) { const bf16_t* pr = PREC + (row0 + r0 + r) * PREC_W; qraw[r] = *(const unsigned*)(pr + qcol + d0); kraw[r] = *(const unsigned*)(pr + kcol + d0);
        graw[r] = IS_A ? 0u : *(const unsigned*)(GDEC + (row0 + r0 + r) * 512 + h * 128 + d0); }
    vraw = *(const u32x4*)(PREC + (row0 + vj) * PREC_W + vcol + ve8);
    u32x4 gate_cur = *(const u32x4*)(PREC + (row0 + vj) * PREC_W + gcol + ve8), gate_nxt = gate_cur, gate_prev = gate_cur;
    f32x4 op0 = (f32x4){0.f, 0.f, 0.f, 0.f}, op1 = op0; float ss_prev = 0.f;
    unsigned long long sg[4] = {0ull, 0ull, 0ull, 0ull};
    __syncthreads();
    float sv[32]; TrTile stile; bool s_have = false;
    stile.sp = nullptr; stile.ldsrc = 0; stile.dst = nullptr; stile.K = 0;
#pragma unroll
    for (int i = 0; i < 32; ++i) sv[i] = 0.f;
    for (int c = 0; c < 32; ++c) {
        float q0[8], q1[8], k0[8], k1[8], P0[8], P1[8];
#pragma unroll
        for (int r = 0; r < 8; ++r) {
            q0[r] = bflo(qraw[r]); q1[r] = bfhi(qraw[r]);
            float a0, a1;
            if (IS_A) { a0 = lb0 + (1.f - lb0) * sigmoidf_(bflo(kraw[r])); a1 = lb1 + (1.f - lb1) * sigmoidf_(bfhi(kraw[r])); k0[r] = 1.f - a0; k1[r] = 1.f - a1; }
            else { a0 = __expf(bflo(graw[r])); a1 = __expf(bfhi(graw[r])); k0[r] = bflo(kraw[r]); k1[r] = bfhi(kraw[r]); }
            P0[r] = r ? P0[r - 1] * a0 : a0; P1[r] = r ? P1[r - 1] * a1 : a1;
        }
        *(float2*)(T8 + wave * 128 + d0) = make_float2(P0[7], P1[7]);
        __syncthreads();
        float T0[4], T1[4];
#pragma unroll
        for (int s = 0; s < 4; ++s) { const float2 x = *(const float2*)(T8 + (2 * s) * 128 + d0), y = *(const float2*)(T8 + (2 * s + 1) * 128 + d0); T0[s] = x.x * y.x; T1[s] = x.y * y.y; }
        float pre0 = 1.f, pre1 = 1.f;
        if (wave & 1) { const float2 x = *(const float2*)(T8 + (wave - 1) * 128 + d0); pre0 = x.x; pre1 = x.y; }
        float R0 = 1.f, R1 = 1.f, U0 = 1.f, U1 = 1.f, Ts0 = 1.f, Ts1 = 1.f;
#pragma unroll
        for (int s = 0; s < 4; ++s) { if (s < sub) { R0 *= T0[s]; R1 *= T1[s]; } if (s > sub) { U0 *= T0[s]; U1 *= T1[s]; } if (s == sub) { Ts0 = T0[s]; Ts1 = T1[s]; } }
        if (wave == 0) *(float2*)(EB + d0) = make_float2(T0[0] * T0[1] * T0[2] * T0[3], T1[0] * T1[1] * T1[2] * T1[3]);
        unsigned kdc0[4], kdc1[4];
        float kprev0 = 0.f, kprev1 = 0.f;
#pragma unroll
        for (int r = 0; r < 8; ++r) {
            const int i = r0 + r;
            const float pl0 = pre0 * P0[r], pl1 = pre1 * P1[r];
            const float iv0 = __builtin_amdgcn_rcpf(pl0), iv1 = __builtin_amdgcn_rcpf(pl1);
            const float ql0 = q0[r] * pl0, ql1 = q1[r] * pl1;
            const float kd0 = k0[r] * iv0, kd1 = k1[r] * iv1;
            const float ke0 = kd0 * Ts0, ke1 = kd1 * Ts1;
            *(unsigned*)(QL + i * RP + d0) = pk2(ql0, ql1);
            *(unsigned*)(QI + i * RP + d0) = pk2(ql0 * R0, ql1 * R1);
            *(unsigned*)(KD + i * RP + d0) = pk2(kd0, kd1);
            *(unsigned*)(KE + i * RP + d0) = pk2(ke0, ke1);
            if (sub == 2) *(unsigned*)(XB + (i - 32) * RP + d0) = pk2(ql0 * T0[1], ql1 * T1[1]);
            if (sub == 3) { *(unsigned*)(XB + (16 + i - 48) * RP + d0) = pk2(ql0 * T0[2], ql1 * T1[2]); *(unsigned*)(XB + (32 + i - 48) * RP + d0) = pk2(ql0 * (T0[1] * T0[2]), ql1 * (T1[1] * T1[2])); }
            const float kc0 = ke0 * U0, kc1 = ke1 * U1;
            if (r & 1) { kdc0[r >> 1] = pk2(kprev0, kc0); kdc1[r >> 1] = pk2(kprev1, kc1); } else { kprev0 = kc0; kprev1 = kc1; }
        }
        *(u32x4*)(KDT + d0 * VP + r0) = (u32x4){kdc0[0], kdc0[1], kdc0[2], kdc0[3]};
        *(u32x4*)(KDT + (d0 + 1) * VP + r0) = (u32x4){kdc1[0], kdc1[1], kdc1[2], kdc1[3]};
#pragma unroll
        for (int q = 0; q < 4; ++q) { VT[(ve8 + 2 * q) * VP + vj] = (bf16_t)(vraw[q] & 0xffffu); VT[(ve8 + 2 * q + 1) * VP + vj] = (bf16_t)(vraw[q] >> 16); }
        if (s_have) tr_to_lds(TT, sv, tid);
        const bool s_store = s_have; const TrTile s_prev = stile;
        {   const int lt = side_first + c * side_stride;
            s_have = side_on && lt < LT_TOTAL;
            if (s_have) { stile = later_tile(p, lt, tid); tr_load(stile, sv); } }
        if (c + 1 < 32) {
            const size_t rn = row0 + (size_t)(c + 1) * 64;
#pragma unroll
            for (int r = 0; r < 8; ++r) { const bf16_t* pr = PREC + (rn + r0 + r) * PREC_W; qraw[r] = *(const unsigned*)(pr + qcol + d0); kraw[r] = *(const unsigned*)(pr + kcol + d0);
                if (!IS_A) graw[r] = *(const unsigned*)(GDEC + (rn + r0 + r) * 512 + h * 128 + d0); }
            vraw = *(const u32x4*)(PREC + (rn + vj) * PREC_W + vcol + ve8);
            gate_nxt = *(const u32x4*)(PREC + (rn + vj) * PREC_W + gcol + ve8);
        }
        __syncthreads();
        if (s_store) tr_store(TT, s_prev, tid);
        if (c > 0) {
#pragma unroll
            for (int k = 0; k < (IS_A ? 2 : 4); ++k) sg[k] = __hip_atomic_load(GR + ((size_t)(sib0 + k) * 32 + (c - 1)) * 64 + vj, __ATOMIC_RELAXED, __HIP_MEMORY_SCOPE_AGENT); }
        f32x4 op[4];
#pragma unroll
        for (int ib = 0; ib < 4; ++ib) op[ib] = (f32x4){0.f, 0.f, 0.f, 0.f};
#pragma unroll
        for (int ks = 0; ks < 2; ++ks) {
            const bf16x8 Bs = mk8(pk2(S[2 * ks][0], S[2 * ks][1]), pk2(S[2 * ks][2], S[2 * ks][3]), pk2(S[2 * ks + 1][0], S[2 * ks + 1][1]), pk2(S[2 * ks + 1][2], S[2 * ks + 1][3]));
#pragma unroll
            for (int ib = 0; ib < 4; ++ib) {
                const bf16_t* qa = QI + (16 * ib + fr) * RP + 64 * dh + 32 * ks + 4 * fq;
                const u32x2 lo = *(const u32x2*)qa, hi = *(const u32x2*)(qa + 16);
                op[ib] = __builtin_amdgcn_mfma_f32_16x16x32_bf16(mk8(lo[0], lo[1], hi[0], hi[1]), Bs, op[ib], 0, 0, 0);
            }
        }
        for (int bi = wave; bi < 10; bi += 8) {
            const int s = bi >= 6 ? 3 : (bi >= 3 ? 2 : (bi >= 1 ? 1 : 0)), r = bi - (s * (s + 1)) / 2, diff = s - r;
            const bf16_t *Ab, *Bb;
            if (diff == 0) { Ab = QL + 16 * s * RP; Bb = KD + 16 * r * RP; }
            else if (diff == 1) { Ab = QL + 16 * s * RP; Bb = KE + 16 * r * RP; }
            else if (diff == 2) { Ab = XB + (s == 2 ? 0 : 16) * RP; Bb = KE + 16 * r * RP; }
            else { Ab = XB + 32 * RP; Bb = KE; }
            f32x4 at = (f32x4){0.f, 0.f, 0.f, 0.f};
#pragma unroll
            for (int ks = 0; ks < 4; ++ks) {
                const bf16x8 av = *(const bf16x8*)(Ab + fr * RP + 32 * ks + 8 * fq), bv = *(const bf16x8*)(Bb + fr * RP + 32 * ks + 8 * fq);
                at = __builtin_amdgcn_mfma_f32_16x16x32_bf16(av, bv, at, 0, 0, 0);
            }
#pragma unroll
            for (int jj = 0; jj < 4; ++jj) { float v = at[jj]; if (diff == 0 && fr > 4 * fq + jj) v = 0.f; AT[(16 * s + 4 * fq + jj) * VP + 16 * r + fr] = (bf16_t)(pk2(v, 0.f) & 0xffffu); }
        }
        __syncthreads();
        {   const bf16x8 bv = *(const bf16x8*)(VT + (16 * eb + fr) * VP + 32 * dh + 8 * fq);
#pragma unroll
            for (int ib = 0; ib < 4; ++ib) {
                if (dh == 1 && ib < 2) continue;
                const bf16x8 av = *(const bf16x8*)(AT + (16 * ib + fr) * VP + 32 * dh + 8 * fq);
                op[ib] = __builtin_amdgcn_mfma_f32_16x16x32_bf16(av, bv, op[ib], 0, 0, 0);
            }
        }
#pragma unroll
        for (int ib = 0; ib < 4; ++ib)
#pragma unroll
            for (int jj = 0; jj < 4; ++jj) OB[(dh * 64 + 16 * ib + 4 * fq + jj) * OBP + 16 * eb + fr] = op[ib][jj];
#pragma unroll
        for (int dt = 0; dt < 4; ++dt) {
            const f32x4 ebv = *(const f32x4*)(EB + 64 * dh + 16 * dt + 4 * fq);
            S[dt] = S[dt] * ebv;
#pragma unroll
            for (int ks = 0; ks < 2; ++ks) {
                const bf16x8 av = *(const bf16x8*)(KDT + (64 * dh + 16 * dt + fr) * VP + 32 * ks + 8 * fq), bv = *(const bf16x8*)(VT + (16 * eb + fr) * VP + 32 * ks + 8 * fq);
                S[dt] = __builtin_amdgcn_mfma_f32_16x16x32_bf16(av, bv, S[dt], 0, 0, 0);
            }
        }
        __syncthreads();
        {   const float* o0 = OB + vj * OBP + ve8; const float* o1 = OB + (64 + vj) * OBP + ve8;
            const f32x4 a0 = *(const f32x4*)o0 + *(const f32x4*)o1, a1 = *(const f32x4*)(o0 + 4) + *(const f32x4*)(o1 + 4);
            float ss = a0[0] * a0[0] + a0[1] * a0[1] + a0[2] * a0[2] + a0[3] * a0[3] + a1[0] * a1[0] + a1[1] * a1[1] + a1[2] * a1[2] + a1[3] * a1[3];
            ss += __shfl_xor(ss, 1); ss += __shfl_xor(ss, 2); ss += __shfl_xor(ss, 4);
            if ((tid & 7) == 0) __hip_atomic_store(GR + ((size_t)item * 32 + c) * 64 + vj, ((unsigned long long)(unsigned)(c + 1) << 32) | (unsigned long long)__float_as_uint(ss), __ATOMIC_RELAXED, __HIP_MEMORY_SCOPE_AGENT);
            if (c > 0) rec_finish<IS_A>(GR, sg, sib0, item, c - 1, vj, ss_prev, op0, op1, nw0, nw1, gate_prev, Y + (row0 + (size_t)(c - 1) * 64 + vj) * DM + ocol + ve8);
            op0 = a0; op1 = a1; ss_prev = ss; gate_prev = gate_cur; gate_cur = gate_nxt;
        }
        __syncthreads();
    }
    {
#pragma unroll
        for (int k = 0; k < (IS_A ? 2 : 4); ++k) sg[k] = __hip_atomic_load(GR + ((size_t)(sib0 + k) * 32 + 31) * 64 + vj, __ATOMIC_RELAXED, __HIP_MEMORY_SCOPE_AGENT);
        rec_finish<IS_A>(GR, sg, sib0, item, 31, vj, ss_prev, op0, op1, nw0, nw1, gate_prev, Y + (row0 + (size_t)31 * 64 + vj) * DM + ocol + ve8);
    }
    if (s_have) { tr_to_lds(TT, sv, tid); __syncthreads(); tr_store(TT, stile, tid); __syncthreads(); }
}
__device__ __forceinline__ void phase_rec2(const Params& p, unsigned char* lds) {
    int nitem = 0;
    for (int item = blockIdx.x; item < 256; item += gridDim.x, ++nitem) {
        if (item < 128) { const int seq = item >> 1; rec_item2<true>(p, lds, item, seq >> 3, seq & 7, item & 1, nitem == 0, (int)blockIdx.x, (int)gridDim.x); }
        else { const int w = item - 128, seq = w >> 2; rec_item2<false>(p, lds, item, seq >> 2, seq & 3, w & 3, nitem == 0, (int)blockIdx.x, (int)gridDim.x); }
    }
    const int tid = opaque_tid();
    for (int lt = (nitem ? (int)blockIdx.x + 32 * (int)gridDim.x : (int)blockIdx.x); lt < LT_TOTAL; lt += gridDim.x) {
        float v[32]; const TrTile t = later_tile(p, lt, tid); tr_load(t, v); tr_to_lds((bf16_t*)(lds + 128256), v, tid); __syncthreads(); tr_store((const bf16_t*)(lds + 128256), t, tid); __syncthreads();
    }
}

__device__ __forceinline__ void phase_y(const Params& p) {
    const int tid = opaque_tid(), lane = tid & 63, wave = tid >> 6;
    const bf16_t* PREC = (const bf16_t*)(p.ws + OFF_PREC);
    const bf16_t* O = (const bf16_t*)p.out + (size_t)NTOK * DM; bf16_t* Y = (bf16_t*)p.out;
    const int rstep = gridDim.x * 8;
    int row = blockIdx.x * 8 + wave;
    u32x4 ov[4], gv[4], on[4], gn[4];
    if (row < NTOK) {
#pragma unroll
        for (int i = 0; i < 4; ++i) { const int col = 512 * i + 8 * lane; ov[i] = *(const u32x4*)(O + (size_t)row * DM + col); gv[i] = *(const u32x4*)(PREC + (size_t)row * PREC_W + (i < 2 ? 3072 + col : 6144 + col - 1024)); }
    }
    for (; row < NTOK; row += rstep) {
        const int rnext = row + rstep < NTOK ? row + rstep : row;
#pragma unroll
        for (int i = 0; i < 4; ++i) { const int col = 512 * i + 8 * lane; on[i] = *(const u32x4*)(O + (size_t)rnext * DM + col); gn[i] = *(const u32x4*)(PREC + (size_t)rnext * PREC_W + (i < 2 ? 3072 + col : 6144 + col - 1024)); }
#pragma unroll
        for (int i = 0; i < 4; ++i) {
            const int col = 512 * i + 8 * lane;
            float o[8] = {bflo(ov[i][0]), bfhi(ov[i][0]), bflo(ov[i][1]), bfhi(ov[i][1]), bflo(ov[i][2]), bfhi(ov[i][2]), bflo(ov[i][3]), bfhi(ov[i][3])};
            float ss = 0.f;
#pragma unroll
            for (int j = 0; j < 8; ++j) ss += o[j] * o[j];
            ss += __shfl_xor(ss, 1); ss += __shfl_xor(ss, 2); ss += __shfl_xor(ss, 4); ss += __shfl_xor(ss, 8);
            float rs; const float* nw;
            if (i < 2) { rs = rsqrtf(ss * (1.f / 128.f) + EPS); nw = p.a_norm_w + (col & 127); }
            else { ss += __shfl_xor(ss, 16); rs = rsqrtf(ss * (1.f / 256.f) + EPS); nw = p.b_norm_w + ((col - 1024) & 255); }
            const f32x4 w0 = *(const f32x4*)nw, w1 = *(const f32x4*)(nw + 4);
            const float g[8] = {bflo(gv[i][0]), bfhi(gv[i][0]), bflo(gv[i][1]), bfhi(gv[i][1]), bflo(gv[i][2]), bfhi(gv[i][2]), bflo(gv[i][3]), bfhi(gv[i][3])};
            float y[8];
#pragma unroll
            for (int j = 0; j < 4; ++j) { y[j] = o[j] * rs * w0[j] * siluf_(g[j]); y[4 + j] = o[4 + j] * rs * w1[j] * siluf_(g[4 + j]); }
            __builtin_nontemporal_store((u32x4){pk2(y[0], y[1]), pk2(y[2], y[3]), pk2(y[4], y[5]), pk2(y[6], y[7])}, (u32x4*)(Y + (size_t)row * DM + col));
        }
#pragma unroll
        for (int i = 0; i < 4; ++i) { ov[i] = on[i]; gv[i] = gn[i]; }
    }
}

__device__ __forceinline__ void phase_h2(const Params& p) {
    const int tid = opaque_tid(), lane = tid & 63, wave = tid >> 6;
    const float* MOD = (const float*)(p.ws + OFF_MOD); bf16_t* H2 = (bf16_t*)p.out; const bf16_t* X1 = (const bf16_t*)(p.ws + OFF_PM);
    const int rstep = gridDim.x * 8;
    int row = blockIdx.x * 8 + wave;
    u32x2 xv[8], xn[8];
    if (row < NTOK) {
#pragma unroll
        for (int i = 0; i < 8; ++i) xv[i] = *(const u32x2*)(X1 + (size_t)row * MP + i * 256 + lane * 4);
    }
    for (; row < NTOK; row += rstep) {
        const int b = row >> 11;
        const int rnext = row + rstep < NTOK ? row + rstep : row;
#pragma unroll
        for (int i = 0; i < 8; ++i) xn[i] = *(const u32x2*)(X1 + (size_t)rnext * MP + i * 256 + lane * 4);
        f32x4 x[8]; float ss = 0.f;
#pragma unroll
        for (int i = 0; i < 8; ++i) { x[i] = (f32x4){bflo(xv[i][0]), bfhi(xv[i][0]), bflo(xv[i][1]), bfhi(xv[i][1])}; ss += x[i][0] * x[i][0] + x[i][1] * x[i][1] + x[i][2] * x[i][2] + x[i][3] * x[i][3]; }
        ss = wave_sum(ss);
        const float rstd = rsqrtf(ss * (1.f / 2048.f) + EPS);
#pragma unroll
        for (int i = 0; i < 8; ++i) {
            const int col = i * 256 + lane * 4;
            const f32x4 w = *(const f32x4*)(p.norm2_w + col), sc = *(const f32x4*)(MOD + (size_t)b * NMOD + 8192 + col), sh = *(const f32x4*)(MOD + (size_t)b * NMOD + 6144 + col);
            f32x4 hv;
#pragma unroll
            for (int j = 0; j < 4; ++j) hv[j] = x[i][j] * rstd * w[j] * (1.f + sc[j]) + sh[j];
            __builtin_nontemporal_store((u32x2){pk2(hv[0], hv[1]), pk2(hv[2], hv[3])}, (u32x2*)(H2 + (size_t)row * DM + col));
        }
#pragma unroll
        for (int i = 0; i < 8; ++i) xv[i] = xn[i];
    }
}
__device__ __forceinline__ void phase_final(const Params& p) {
    const int tid = opaque_tid(), lane = tid & 63, wave = tid >> 6;
    const bf16_t* X2 = (const bf16_t*)(p.ws + OFF_PM);
    const int rstep = gridDim.x * 8;
    int row = blockIdx.x * 8 + wave;
    u32x2 xv[8], xn[8];
    if (row < NTOK) {
#pragma unroll
        for (int i = 0; i < 8; ++i) xv[i] = *(const u32x2*)(X2 + (size_t)row * MP + i * 256 + lane * 4);
    }
    for (; row < NTOK; row += rstep) {
        const int rnext = row + rstep < NTOK ? row + rstep : row;
#pragma unroll
        for (int i = 0; i < 8; ++i) xn[i] = *(const u32x2*)(X2 + (size_t)rnext * MP + i * 256 + lane * 4);
        f32x4 x[8]; float ss = 0.f;
#pragma unroll
        for (int i = 0; i < 8; ++i) { x[i] = (f32x4){bflo(xv[i][0]), bfhi(xv[i][0]), bflo(xv[i][1]), bfhi(xv[i][1])}; ss += x[i][0] * x[i][0] + x[i][1] * x[i][1] + x[i][2] * x[i][2] + x[i][3] * x[i][3]; }
        ss = wave_sum(ss);
        const float rstd = rsqrtf(ss * (1.f / 2048.f) + EPS);
        float* xr = p.out + (size_t)row * DM;
#pragma unroll
        for (int i = 0; i < 8; ++i) {
            const int col = i * 256 + lane * 4;
            const f32x4 w = *(const f32x4*)(p.final_norm_w + col);
            __builtin_nontemporal_store(x[i] * rstd * w, (f32x4*)(xr + col));
        }
#pragma unroll
        for (int i = 0; i < 8; ++i) xv[i] = xn[i];
    }
}

#define XB_TMO      128
#define XB_XCNT(j)  (256  + 64 * (j))
#define XB_XSUB(j)  (1280 + 64 * (j))
#define XB_XGEN(j)  (2304 + 64 * (j))
#define XB_TOP      3328
#define XB_TOPGEN   3392
#define XCD_BAR_WORDS 3456
#define XB_SPIN_CAP (1u << 20)
__device__ __forceinline__ unsigned xb_ld(unsigned* p)              { return __hip_atomic_load(p, __ATOMIC_RELAXED, __HIP_MEMORY_SCOPE_AGENT); }
__device__ __forceinline__ unsigned xb_add(unsigned* p, unsigned v) { return __hip_atomic_fetch_add(p, v, __ATOMIC_RELAXED, __HIP_MEMORY_SCOPE_AGENT); }
__device__ __forceinline__ unsigned xb_xcc_id() { return (unsigned)__builtin_amdgcn_s_getreg((3 << 11) | 20) & 0xFu; }
#define XB_SPIN(cond, bar) do { unsigned _sp = 0; while (cond) { __builtin_amdgcn_s_sleep(1); \
    if ((++_sp & 255u) == 0u) { if (xb_ld(&(bar)[XB_TMO])) break; if (_sp > XB_SPIN_CAP) { atomicAdd(&(bar)[XB_TMO], 1u); break; } } } } while (0)
struct XcdBarrier { unsigned* bar; unsigned x; volatile LAS unsigned* st; };
__device__ __forceinline__ XcdBarrier xcd_barrier_post(unsigned* bar, volatile LAS unsigned* st) {
    XcdBarrier b; b.bar = bar; b.x = xb_xcc_id(); b.st = st;
    if (threadIdx.x == 0) (void)xb_add(&bar[XB_XCNT(b.x)], 1u);
    return b;
}
__device__ __forceinline__ void xcd_barrier_complete(unsigned* bar, unsigned x, unsigned& nloc, unsigned& nx) {
    const unsigned G = gridDim.x * gridDim.y * gridDim.z;
    unsigned sum, cnt, mine, sp = 0u;
    for (;;) {
        sum = 0u; cnt = 0u; mine = 0u;
#pragma unroll
        for (unsigned j = 0; j < 16; ++j) { const unsigned c = xb_ld(&bar[XB_XCNT(j)]); sum += c; cnt += (c > 0u) ? 1u : 0u; mine = (j == x) ? c : mine; }
        if (sum == G) break;
        __builtin_amdgcn_s_sleep(1);
        if ((++sp & 255u) == 0u) { if (xb_ld(&bar[XB_TMO])) break; if (sp > XB_SPIN_CAP) { atomicAdd(&bar[XB_TMO], 1u); break; } }
    }
    nloc = mine > 0u ? mine : 1u; nx = cnt > 0u ? cnt : 1u;
}
__device__ __forceinline__ void xcd_barrier(const XcdBarrier& b) {
    asm volatile("s_waitcnt vmcnt(0)" ::: "memory");
    __syncthreads();
    if (threadIdx.x == 0) {
        unsigned* bar = b.bar;
        __builtin_amdgcn_s_waitcnt(0);
        unsigned nloc = b.st[0], nx = b.st[1];
        if (nloc == 0u) { xcd_barrier_complete(bar, b.x, nloc, nx); b.st[0] = nloc; b.st[1] = nx; }
        const unsigned old = xb_add(&bar[XB_XSUB(b.x)], 1u);
        const unsigned gen = old / nloc;
        if (old + 1u == (gen + 1u) * nloc) {
            __builtin_amdgcn_fence(__ATOMIC_RELEASE, "agent");
            asm volatile("s_waitcnt vmcnt(0)" ::: "memory");
            const unsigned og = xb_add(&bar[XB_TOP], 1u);
            const unsigned tg = og / nx;
            if (og + 1u == (tg + 1u) * nx) xb_add(&bar[XB_TOPGEN], 1u);
            else XB_SPIN(xb_ld(&bar[XB_TOPGEN]) == tg, bar);
            __builtin_amdgcn_fence(__ATOMIC_ACQUIRE, "agent");
            xb_add(&bar[XB_XGEN(b.x)], 1u);
            asm volatile("s_waitcnt vmcnt(0)" ::: "memory");
        } else {
            XB_SPIN(xb_ld(&bar[XB_XGEN(b.x)]) == gen, bar);
            __builtin_amdgcn_fence(__ATOMIC_ACQUIRE, "agent");
            asm volatile("s_waitcnt vmcnt(0)" ::: "memory");
        }
    }
    __syncthreads();
}

__device__ __forceinline__ pg8::Sched make_sched(int nN, int pairs, const void* A0, const void* A1, size_t atile, const void* B0, const void* B1, size_t btile) {
    pg8::Sched S; S.nM = NTOK / 256; S.nN = nN; S.nwg = S.nM * nN; S.G = gridDim.x; S.c = blockIdx.x; S.pairs = pairs;
    S.A0 = (const char*)A0; S.A1 = (const char*)A1; S.B0 = (const char*)B0; S.B1 = (const char*)B1; S.atile = atile; S.btile = btile; return S;
}

__global__ void __launch_bounds__(512, 2) fwd_kernel(const Params p) {
    extern __shared__ __attribute__((aligned(16))) unsigned char shm[];
    cg::grid_group grid = cg::this_grid();
    LAS unsigned char* lds = (LAS unsigned char*)shm;
    unsigned char* ws = p.ws;
    volatile LAS unsigned* xst = (volatile LAS unsigned*)(lds + XST_OFF);
    if (threadIdx.x == 0) { xst[0] = 0u; xst[1] = 0u; }
    __syncthreads();
    const XcdBarrier xb = xcd_barrier_post((unsigned*)(ws + OFF_BAR), xst);
    if (p.phase_hi > NPHASE) grid.sync();
#if USE_CG_SYNC
#define GSYNC() grid.sync()
#else
#define GSYNC() xcd_barrier(xb)
#endif
#ifndef PH_MASK
#define PH_MASK 0x7ff
#endif
#ifndef REPEAT_MASK
#define REPEAT_MASK 0
#endif
#define PHASE(n) if ((((PH_MASK) >> (n)) & 1) && p.phase_lo <= (n) && (n) < p.phase_hi) { if ((n) > p.phase_lo) GSYNC(); for (int rep_ = 0; rep_ <= (((REPEAT_MASK) >> (n)) & 1); ++rep_) { if (rep_) GSYNC();
#define PHASE_END } }
    PHASE(0) phase_prep(p, shm); PHASE_END
    PHASE(1) phase_h(p, shm); PHASE_END
    PHASE(2) { const pg8::Sched S = make_sched(44, 0, p.out, p.out, (size_t)256 * DM * 2, ws + OFF_WT_IN, ws + OFF_WT_IN, (size_t)256 * 2048 * 2);
               EpiG1 E; E.prec = (bf16_t*)(ws + OFF_PREC); E.pm_ = (bf16_t*)(ws + OFF_PM);
               pg8::gemm_phase(lds, 2048, DM, 2048, S, E); } PHASE_END
        PHASE(3) phase_rec2(p, shm); PHASE_END
    PHASE(5) { const pg8::Sched S = make_sched(8, 1, p.out, (const char*)p.out + 1024 * 2, (size_t)256 * DM * 2, ws + OFF_WT_UPA, ws + OFF_WT_UPB, (size_t)256 * 1024 * 2);
               EpiG2 E; E.merged = (bf16_t*)(ws + OFF_PREC); E.pm_ = (const bf16_t*)(ws + OFF_PM);
               pg8::gemm_phase(lds, 1024, DM, 1024, S, E); } PHASE_END
    PHASE(6) { const pg8::Sched S = make_sched(8, 0, ws + OFF_PREC, ws + OFF_PREC, (size_t)256 * DM * 2, ws + OFF_WT_O, ws + OFF_WT_O, (size_t)256 * 2048 * 2);
               EpiResT<false> E; E.xin = p.x; E.ldi = DM; E.xout = (bf16_t*)(ws + OFF_PM); E.ldo = MP; E.gt = (const float*)(ws + OFF_MOD) + 4096;
               pg8::gemm_phase(lds, 2048, DM, 2048, S, E); } PHASE_END
    PHASE(7) phase_h2(p); PHASE_END
    PHASE(8) { const pg8::Sched S = make_sched(44, 0, p.out, p.out, (size_t)256 * DM * 2, ws + OFF_WT_FFI, ws + OFF_WT_FFI, (size_t)256 * 2048 * 2);
               EpiG4 E; E.actb = (bf16_t*)(ws + OFF_PREC);
               pg8::gemm_phase(lds, 2048, DM, 2048, S, E); } PHASE_END
    PHASE(9) { const pg8::Sched S = make_sched(8, 0, ws + OFF_PREC, ws + OFF_PREC, (size_t)256 * FFH * 2, ws + OFF_WT_FFO, ws + OFF_WT_FFO, (size_t)256 * FFH * 2);
               EpiResT<true> E; E.xin = ws + OFF_PM; E.ldi = MP; E.xout = (bf16_t*)(ws + OFF_PM); E.ldo = MP; E.gt = (const float*)(ws + OFF_MOD) + 10240;
               pg8::gemm_phase(lds, FFH, FFH, FFH, S, E); } PHASE_END
    PHASE(10) phase_final(p); PHASE_END
#ifndef EXTRA_SYNCS
#define EXTRA_SYNCS 0
#endif
    for (int i = 0; i < EXTRA_SYNCS; ++i) GSYNC();
#undef PHASE
#undef PHASE_END
}

extern "C" void kernel_launch(void* const* d_in, const int* in_sizes, int n_in, void* d_out, int out_size, void* d_ws, size_t ws_size, hipStream_t stream) {
    static int grid = 0;
    if (grid == 0) {
        if (n_in != 18 || ws_size < WS_END) { fprintf(stderr, "kernel_launch: need 18 inputs and >= %zu bytes of workspace; got %d, %zu\n", (size_t)WS_END, n_in, ws_size); grid = -1; return; }
        int dev = 0, cus = 0, per_cu = 0;
        hipGetDevice(&dev);
        hipDeviceGetAttribute(&cus, hipDeviceAttributeMultiprocessorCount, dev);
        if (hipFuncSetAttribute((const void*)fwd_kernel, hipFuncAttributeMaxDynamicSharedMemorySize, LDS_BYTES) != hipSuccess) fprintf(stderr, "kernel_launch: hipFuncSetAttribute failed\n");
        if (hipOccupancyMaxActiveBlocksPerMultiprocessor(&per_cu, (const void*)fwd_kernel, 512, LDS_BYTES) != hipSuccess || per_cu < 1) { fprintf(stderr, "kernel_launch: occupancy query says %d\n", per_cu); per_cu = 1; }
        (void)hipGetLastError();
        grid = cus * 1;
    }
    if (grid < 0) return;
    (void)hipMemsetAsync((unsigned char*)d_ws + OFF_BAR, 0, BAR_BYTES, stream);
    Params p{};
    p.x = (const float*)d_in[0]; p.c = (const float*)d_in[1]; p.w_ada = (const float*)d_in[2]; p.b_ada = (const float*)d_in[3]; p.norm1_w = (const float*)d_in[4];
    p.w_in = (const float*)d_in[5]; p.w_gk2 = (const float*)d_in[6]; p.b_gk2 = (const float*)d_in[7]; p.lb_param = (const float*)d_in[8]; p.a_norm_w = (const float*)d_in[9];
    p.b_norm_w = (const float*)d_in[10]; p.w_up_a = (const float*)d_in[11]; p.w_up_b = (const float*)d_in[12]; p.w_o = (const float*)d_in[13]; p.norm2_w = (const float*)d_in[14];
    p.w_ffn_in = (const float*)d_in[15]; p.w_ffn_out = (const float*)d_in[16]; p.final_norm_w = (const float*)d_in[17];
    p.out = (float*)d_out; p.ws = (unsigned char*)d_ws;
#if ONE_LAUNCH
    p.phase_lo = 0; p.phase_hi = NPHASE;
    void* args[] = {(void*)&p};
    hipError_t e = hipLaunchCooperativeKernel((const void*)fwd_kernel, dim3(grid), dim3(512), args, LDS_BYTES, stream);
    if (e != hipSuccess) fprintf(stderr, "cooperative launch failed: %s (grid %d)\n", hipGetErrorString(e), grid);
#else
    for (int ph = 0; ph < NPHASE; ++ph) {
        p.phase_lo = ph; p.phase_hi = ph + 1;
        hipLaunchKernelGGL(fwd_kernel, dim3(grid), dim3(512), LDS_BYTES, stream, p);
    }
#endif
}
```
